# Optimizing an MI355X kernel written in HIP

```python
import functools
import jax, jax.numpy as jnp
from jax import lax
import numpy as np

D_MODEL = 1024
BATCH = 4
SEQ = 8192
DEPTH = 2
DEC_BATCH = 32
DEC_SEQ = 1
PAST_LEN = 16384
PAGE_SIZE = 128

N_HEADS = 8
HEAD_DIM = 64
D_ATTN = N_HEADS * HEAD_DIM
D_CONV = D_MODEL // 4
CONV_WIDTH = 31
D_SCONV = D_MODEL // 4
SCONV_WIDTH = 3
D_MIX = D_ATTN + D_CONV + D_SCONV
WINDOWS = (128, 512, 2048)
DILATIONS = (1, 4, 16)
MAX_WINDOW = 2048
ROPE_THETA = 10000.0
EPS = 1e-6
Q_BLOCK = 128
IN_SIZES = (D_ATTN, D_ATTN, D_ATTN, D_ATTN,
            D_CONV, D_CONV, D_CONV,
            D_SCONV, D_SCONV, D_SCONV, D_SCONV)
D_IN = 4 * D_ATTN + 3 * D_CONV + 4 * D_SCONV

kernel_name = 'hymba_longnet_conformer_shortconv_step'


def rmsnorm(x, g):
    xf = x.astype(jnp.float32)
    y = xf * lax.rsqrt(jnp.mean(xf * xf, axis=-1, keepdims=True) + EPS)
    return (y * g.astype(jnp.float32)).astype(x.dtype)


def layernorm(x, g, b):
    xf = x.astype(jnp.float32)
    mu = jnp.mean(xf, axis=-1, keepdims=True)
    var = jnp.mean(jnp.square(xf - mu), axis=-1, keepdims=True)
    y = (xf - mu) * lax.rsqrt(var + EPS) * g.astype(jnp.float32) + b.astype(jnp.float32)
    return y.astype(x.dtype)


def rope(x, pos):
    half = HEAD_DIM // 2
    inv = ROPE_THETA ** (-jnp.arange(half, dtype=jnp.float32) / half)
    ang = pos.astype(jnp.float32)[:, None] * inv[None, :]
    cos = jnp.cos(ang)[None, :, None, :]
    sin = jnp.sin(ang)[None, :, None, :]
    xf = x.astype(jnp.float32)
    x1, x2 = xf[..., :half], xf[..., half:]
    return jnp.concatenate([x1 * cos - x2 * sin, x2 * cos + x1 * sin], axis=-1).astype(x.dtype)


def causal_dwconv(u_full, w):
    c = u_full.shape[-1]
    return lax.conv_general_dilated(u_full, w[:, None, :].astype(u_full.dtype), (1,), 'VALID',
                                    dimension_numbers=('NWC', 'WIO', 'NWC'),
                                    feature_group_count=c)


def longnet_attend(q, k_all, v_all, self_idx):
    qf = q.astype(jnp.float32) * (HEAD_DIM ** -0.5)
    scores, vals = [], []
    for w, d in zip(WINDOWS, DILATIONS):
        offs = d * jnp.arange(w // d + 1, dtype=jnp.int32)
        idx = self_idx[:, None] - offs[None, :]
        valid = idx >= 0
        idxc = jnp.maximum(idx, 0)
        kg = k_all[:, idxc]
        vals.append(v_all[:, idxc])
        s = jnp.einsum('bqhd,bqjhd->bhqj', qf, kg.astype(jnp.float32))
        scores.append(jnp.where(valid[None, None], s, -jnp.inf))
    m = functools.reduce(jnp.maximum, [s.max(axis=-1, keepdims=True) for s in scores])
    outs, dens = [], []
    for s, vg in zip(scores, vals):
        e = jnp.exp(s - m)
        den = e.sum(axis=-1).transpose(0, 2, 1)[..., None]
        num = jnp.einsum('bhqj,bqjhd->bqhd', e, vg.astype(jnp.float32))
        outs.append(num / den)
        dens.append(den)
    den_tot = functools.reduce(jnp.add, dens)
    out = functools.reduce(jnp.add, [(dn / den_tot) * o for dn, o in zip(dens, outs)])
    return out.astype(q.dtype)


def prompt_attention(q, k, v):
    b, s = q.shape[:2]
    nb = s // Q_BLOCK
    qb = q.reshape(b, nb, Q_BLOCK, N_HEADS, HEAD_DIM).transpose(1, 0, 2, 3, 4)
    starts = jnp.arange(nb, dtype=jnp.int32) * Q_BLOCK

    def one_block(args):
        qi, t0 = args
        return longnet_attend(qi, k, v, t0 + jnp.arange(Q_BLOCK, dtype=jnp.int32))

    o = lax.map(one_block, (qb, starts))
    return o.transpose(1, 0, 2, 3, 4).reshape(b, s, N_HEADS, HEAD_DIM)


def in_proj(x, pos, ln_g, w_in, qn_g, kn_g):
    b, t = x.shape[:2]
    xn = rmsnorm(x, ln_g)
    p = xn @ w_in
    cuts = [int(c) for c in np.cumsum(IN_SIZES)[:-1]]
    q, k, v, z_attn, a_val, a_gate, z_a, c_b, c_c, c_h, z_c = jnp.split(p, cuts, axis=-1)
    q = rope(rmsnorm(q.reshape(b, t, N_HEADS, HEAD_DIM), qn_g), pos)
    k = rope(rmsnorm(k.reshape(b, t, N_HEADS, HEAD_DIM), kn_g), pos)
    v = v.reshape(b, t, N_HEADS, HEAD_DIM)
    return q, k, v, z_attn, (a_val, a_gate, z_a), (c_b, c_c, c_h, z_c)


def conv_branches(a_parts, c_parts, hist_a, hist_c, a_w, a_b, a_g, a_lb, c_w):
    a_val, a_gate, z_a = a_parts
    u = a_val * jax.nn.sigmoid(a_gate)
    ua = jnp.concatenate([hist_a.astype(u.dtype), u], axis=1)
    ca = causal_dwconv(ua, a_w) + a_b.astype(u.dtype)
    ya = jax.nn.silu(layernorm(ca, a_g, a_lb)) * jax.nn.silu(z_a)
    c_b, c_c, c_h, z_c = c_parts
    uc = c_c * c_h
    ucf = jnp.concatenate([hist_c.astype(uc.dtype), uc], axis=1)
    yc = c_b * causal_dwconv(ucf, c_w) * jax.nn.silu(z_c)
    return ya, yc, ua[:, -(CONV_WIDTH - 1):], ucf[:, -(SCONV_WIDTH - 1):]


def out_proj(x, attn, z_attn, ya, yc, w_out):
    b, t = x.shape[:2]
    ya_attn = attn.reshape(b, t, D_ATTN) * jax.nn.silu(z_attn)
    return x + jnp.concatenate([ya_attn, ya, yc], axis=-1) @ w_out


def setup_inputs(seed: int = 0) -> dict:
    key = jax.random.key(seed)
    ks = jax.random.split(key, 20)
    f32 = jnp.float32
    l_cache = min(MAX_WINDOW, PAST_LEN)
    nrm = lambda k, shape, s: jax.random.normal(k, shape, f32) * s
    return {
        'x_prompt': nrm(ks[0], (BATCH, SEQ, D_MODEL), 1.0),
        'x_sample': nrm(ks[1], (DEC_BATCH, DEC_SEQ, D_MODEL), 1.0),
        'cache_k': nrm(ks[2], (DEPTH, DEC_BATCH, l_cache, N_HEADS, HEAD_DIM), 1.0),
        'cache_v': nrm(ks[3], (DEPTH, DEC_BATCH, l_cache, N_HEADS, HEAD_DIM), 1.0),
        'state_conv_a': nrm(ks[4], (DEPTH, DEC_BATCH, CONV_WIDTH - 1, D_CONV), 0.5),
        'state_conv_c': nrm(ks[5], (DEPTH, DEC_BATCH, SCONV_WIDTH - 1, D_SCONV), 0.5),
        'ln_g': 1.0 + nrm(ks[6], (DEPTH, D_MODEL), 0.01),
        'w_in': nrm(ks[7], (DEPTH, D_MODEL, D_IN), D_MODEL ** -0.5),
        'q_norm_g': 1.0 + nrm(ks[8], (DEPTH, HEAD_DIM), 0.01),
        'k_norm_g': 1.0 + nrm(ks[9], (DEPTH, HEAD_DIM), 0.01),
        'a_conv_w': nrm(ks[10], (DEPTH, CONV_WIDTH, D_CONV), CONV_WIDTH ** -0.5),
        'a_conv_b': nrm(ks[11], (DEPTH, D_CONV), 0.02),
        'a_ln_g': 1.0 + nrm(ks[12], (DEPTH, D_CONV), 0.01),
        'a_ln_b': nrm(ks[13], (DEPTH, D_CONV), 0.02),
        'c_conv_w': nrm(ks[14], (DEPTH, SCONV_WIDTH, D_SCONV), SCONV_WIDTH ** -0.5),
        'w_out': nrm(ks[15], (DEPTH, D_MIX, D_MODEL), D_MIX ** -0.5),
    }


def reference(x_prompt, x_sample, cache_k, cache_v, state_conv_a, state_conv_c,
              ln_g, w_in, q_norm_g, k_norm_g, a_conv_w, a_conv_b, a_ln_g, a_ln_b,
              c_conv_w, w_out):
    bp, sp = x_prompt.shape[:2]
    ts = x_sample.shape[1]
    l_prompt = min(MAX_WINDOW, sp)
    l_cache = cache_k.shape[2]
    pos_p = jnp.arange(sp, dtype=jnp.int32)
    pos_s = PAST_LEN + jnp.arange(ts, dtype=jnp.int32)
    hp, hs = x_prompt, x_sample
    pk, pv, pa, pc, sk, sv, sa, sc = [], [], [], [], [], [], [], []
    for l in range(DEPTH):
        q, k, v, z, ap, cp = in_proj(hp, pos_p, ln_g[l], w_in[l], q_norm_g[l], k_norm_g[l])
        attn = prompt_attention(q, k, v)
        zero_a = jnp.zeros((bp, CONV_WIDTH - 1, D_CONV), hp.dtype)
        zero_c = jnp.zeros((bp, SCONV_WIDTH - 1, D_SCONV), hp.dtype)
        ya, yc, na, nc = conv_branches(ap, cp, zero_a, zero_c, a_conv_w[l], a_conv_b[l],
                                       a_ln_g[l], a_ln_b[l], c_conv_w[l])
        hp = out_proj(hp, attn, z, ya, yc, w_out[l])
        pk.append(k[:, sp - l_prompt:])
        pv.append(v[:, sp - l_prompt:])
        pa.append(na)
        pc.append(nc)
        q, k, v, z, ap, cp = in_proj(hs, pos_s, ln_g[l], w_in[l], q_norm_g[l], k_norm_g[l])
        k_all = jnp.concatenate([cache_k[l].astype(k.dtype), k], axis=1)
        v_all = jnp.concatenate([cache_v[l].astype(v.dtype), v], axis=1)
        attn = longnet_attend(q, k_all, v_all, l_cache + jnp.arange(ts, dtype=jnp.int32))
        ya, yc, na, nc = conv_branches(ap, cp, state_conv_a[l], state_conv_c[l], a_conv_w[l],
                                       a_conv_b[l], a_ln_g[l], a_ln_b[l], c_conv_w[l])
        hs = out_proj(hs, attn, z, ya, yc, w_out[l])
        sk.append(k_all[:, -l_cache:])
        sv.append(v_all[:, -l_cache:])
        sa.append(na)
        sc.append(nc)
    return (hp, hs, jnp.stack(pk), jnp.stack(pv), jnp.stack(pa), jnp.stack(pc),
            jnp.stack(sk), jnp.stack(sv), jnp.stack(sa), jnp.stack(sc))
```

```cpp
#include <hip/hip_runtime.h>
#include <cstdint>
#include <cstdio>

constexpr int DM = 1024, NB = 4, SEQ = 8192, NP = NB * SEQ  , NS = 32, NR = NP + NS  ;
constexpr int DIN = 3840, NH = 8, HD = 64, LC = 2048, PAST = 16384;
constexpr float EPS = 1e-6f;
constexpr int C_Q = 0, C_K = 512, C_V = 1024, C_Z = 1536, C_AV = 2048, C_AG = 2304, C_ZA = 2560, C_CB = 2816, C_CC = 3072, C_CH = 3328, C_ZC = 3584;
constexpr size_t O_Y = 0, O_YS = 33554432, O_KP = 33587200, O_VP = 41975808, O_AP = 50364416, O_CP = 50425856,
                 O_KS = 50429952, O_VS = 117538816, O_AS = 184647680, O_CS = 185139200, O_END = 185171968;

__device__ __constant__ double ROPE_INV[32] = {
    1.0, 0.7498942093324559, 0.5623413251903491, 0.4216965034285822, 0.31622776601683794, 0.23713737056616552, 0.1778279410038923, 0.1333521432163324,
    0.1, 0.07498942093324558, 0.05623413251903491, 0.042169650342858224, 0.03162277660168379, 0.023713737056616554, 0.01778279410038923, 0.01333521432163324,
    0.01, 0.007498942093324558, 0.005623413251903491, 0.004216965034285823, 0.0031622776601683794, 0.0023713737056616554, 0.0017782794100389228, 0.001333521432163324,
    0.001, 0.0007498942093324559, 0.0005623413251903491, 0.00042169650342858224, 0.00031622776601683794, 0.00023713737056616554, 0.00017782794100389227, 0.0001333521432163324};

__device__ __forceinline__ float wave_sum(float v) {
#pragma unroll
    for (int o = 1; o < 64; o <<= 1) v += __shfl_xor(v, o);
    return v;
}
__device__ __forceinline__ float wave_max(float v) {
#pragma unroll
    for (int o = 1; o < 64; o <<= 1) v = fmaxf(v, __shfl_xor(v, o));
    return v;
}
__device__ __forceinline__ float sigmoidf_(float x) { return 1.0f / (1.0f + __expf(-x)); }
__device__ __forceinline__ float siluf_(float x) { return x * sigmoidf_(x); }
__device__ __forceinline__ void rope_cs(int pos, int i, float& c, float& s) {
    const double ang = (double)pos * ROPE_INV[i];
    const double n = rint(ang * 0.15915494309189535);
    const float r = (float)fma(-n, 6.283185307179586, ang);
    c = cosf(r); s = sinf(r);
}

__global__ void __launch_bounds__(256) nv_cache_copy(const float* ck, const float* cv, float* out) {
    const size_t nthr = (size_t)gridDim.x * blockDim.x, tid = (size_t)blockIdx.x * blockDim.x + threadIdx.x;
    const size_t per = (size_t)LC * 512 / 4;
    for (size_t i = tid; i < 64 * per; i += nthr) {
        const size_t lb = i / per, r = i % per;
        if (r / 128 < LC - 1) {
            ((float4*)(out + O_KS))[i] = ((const float4*)ck)[lb * per + r + 128];
            ((float4*)(out + O_VS))[i] = ((const float4*)cv)[lb * per + r + 128];
        }
    }
}

__global__ void __launch_bounds__(256) nv_rmsnorm(const float* xp, const float* xs, const float* g, float* xn) {
    const int lane = threadIdx.x & 63, r = blockIdx.x * 4 + (threadIdx.x >> 6);
    if (r >= NR) return;
    const float* x = r < NP ? xp + (size_t)r * DM : xs + (size_t)(r - NP) * DM;
    float4 v[4]; float ss = 0.f;
#pragma unroll
    for (int j = 0; j < 4; ++j) { v[j] = ((const float4*)x)[lane + 64 * j]; ss += v[j].x * v[j].x + v[j].y * v[j].y + v[j].z * v[j].z + v[j].w * v[j].w; }
    const float rstd = rsqrtf(wave_sum(ss) * (1.f / DM) + EPS);
#pragma unroll
    for (int j = 0; j < 4; ++j) {
        const float4 gg = ((const float4*)g)[lane + 64 * j];
        float4 o; o.x = v[j].x * rstd * gg.x; o.y = v[j].y * rstd * gg.y; o.z = v[j].z * rstd * gg.z; o.w = v[j].w * rstd * gg.w;
        ((float4*)(xn + (size_t)r * DM))[lane + 64 * j] = o;
    }
}

template <bool RES> __global__ void __launch_bounds__(256) nv_gemm(const float* A, const float* B, float* C, int M, int N, int K, const float* rp, const float* rs) {
    __shared__ float As[16][68];
    __shared__ float Bs[16][64];
    const int tid = threadIdx.x, tx = tid & 15, ty = tid >> 4;
    const int m0 = blockIdx.y * 64, n0 = blockIdx.x * 64;
    float acc[4][4] = {};
    for (int k0 = 0; k0 < K; k0 += 16) {
        {
            const int row = tid >> 2, kk = (tid & 3) * 4, gr = m0 + row;
            float4 a = make_float4(0.f, 0.f, 0.f, 0.f);
            if (gr < M) a = *(const float4*)(A + (size_t)gr * K + k0 + kk);
            As[kk + 0][row] = a.x; As[kk + 1][row] = a.y; As[kk + 2][row] = a.z; As[kk + 3][row] = a.w;
            const int bk = tid >> 4, bn = (tid & 15) * 4;
            *(float4*)&Bs[bk][bn] = *(const float4*)(B + (size_t)(k0 + bk) * N + n0 + bn);
        }
        __syncthreads();
#pragma unroll
        for (int k = 0; k < 16; ++k) {
            const float4 a = *(const float4*)&As[k][ty * 4];
            const float4 b = *(const float4*)&Bs[k][tx * 4];
            const float av[4] = {a.x, a.y, a.z, a.w}, bv[4] = {b.x, b.y, b.z, b.w};
#pragma unroll
            for (int i = 0; i < 4; ++i)
#pragma unroll
                for (int j = 0; j < 4; ++j) acc[i][j] = fmaf(av[i], bv[j], acc[i][j]);
        }
        __syncthreads();
    }
#pragma unroll
    for (int i = 0; i < 4; ++i) {
        const int gr = m0 + ty * 4 + i;
        if (gr < M) {
            float4 o = make_float4(acc[i][0], acc[i][1], acc[i][2], acc[i][3]);
            if (RES) {
                const float* rr = gr < NP ? rp + (size_t)gr * N : rs + (size_t)(gr - NP) * N;
                const float4 x = *(const float4*)(rr + n0 + tx * 4);
                o.x += x.x; o.y += x.y; o.z += x.z; o.w += x.w;
            }
            *(float4*)(C + (size_t)gr * N + n0 + tx * 4) = o;
        }
    }
}

__global__ void __launch_bounds__(256) nv_qkv_post(float* P, const float* qg, const float* kg, float* out, int l) {
    const int lane = threadIdx.x & 63;
    const long item = (long)blockIdx.x * 4 + (threadIdx.x >> 6);
    if (item >= (long)NR * NH * 3) return;
    const int which = (int)(item % 3), h = (int)((item / 3) % NH), r = (int)(item / (3 * NH));
    const bool smp = r >= NP; const int b = smp ? r - NP : r / SEQ, t = smp ? 0 : r % SEQ, pos = smp ? PAST : t;
    float* p = P + (size_t)r * DIN + which * 512 + h * HD + lane;
    float y = *p;
    if (which < 2) {
        const float ss = wave_sum(y * y);
        y = y * rsqrtf(ss * (1.f / HD) + EPS) * (which == 0 ? qg : kg)[lane];
        const float partner = __shfl_xor(y, 32);
        float c, s; rope_cs(pos, lane & 31, c, s);
        y = lane < 32 ? y * c - partner * s : y * c + partner * s;
        *p = y;
    }
    if (which >= 1) {
        const size_t ob = which == 1 ? (smp ? O_KS : O_KP) : (smp ? O_VS : O_VP);
        if (smp) out[ob + (((size_t)(l * NS + b) * LC + (LC - 1)) * NH + h) * HD + lane] = y;
        else if (t >= SEQ - LC) out[ob + (((size_t)(l * NB + b) * LC + (t - (SEQ - LC))) * NH + h) * HD + lane] = y;
    }
}

__global__ void __launch_bounds__(256) nv_attn(const float* P, const float* ck, const float* cv, float* MIX, int l) {
    __shared__ float sc_all[4][400];
    __shared__ float q_all[4][64];
    const int lane = threadIdx.x & 63, w = threadIdx.x >> 6;
    const int item = blockIdx.x * 4 + w;
    const int h = item % NH, r = item / NH;
    const bool smp = r >= NP; const int b = smp ? r - NP : r / SEQ, t = smp ? 0 : r % SEQ;
    float* sc = sc_all[w]; float* qs = q_all[w];
    qs[lane] = P[(size_t)r * DIN + C_Q + h * HD + lane] * 0.125f;
    __builtin_amdgcn_s_waitcnt(0);
    const int self_idx = smp ? LC : t;
    float mloc = -INFINITY;
    for (int e = lane; e < 387; e += 64) {
        const int p = e / 129, j = e % 129, D = p == 0 ? 1 : (p == 1 ? 4 : 16);
        const int idx = self_idx - j * D;
        float s = -INFINITY;
        if (idx >= 0) {
            const float* kr;
            if (!smp) kr = P + (size_t)(b * SEQ + idx) * DIN + C_K + h * HD;
            else kr = j == 0 ? P + (size_t)r * DIN + C_K + h * HD : ck + (((size_t)(l * NS + b) * LC + idx) * NH + h) * HD;
            float a = 0.f;
#pragma unroll 4
            for (int d = 0; d < HD; d += 4) { const float4 kv = *(const float4*)(kr + d); a += qs[d] * kv.x + qs[d + 1] * kv.y + qs[d + 2] * kv.z + qs[d + 3] * kv.w; }
            s = a;
        }
        sc[e] = s; mloc = fmaxf(mloc, s);
    }
    const float m = wave_max(mloc);
    float lsum = 0.f;
    for (int e = lane; e < 387; e += 64) { const float ev = __expf(sc[e] - m); sc[e] = ev; lsum += ev; }
    const float den = wave_sum(lsum);
    __builtin_amdgcn_s_waitcnt(0);
    float acc = 0.f;
#pragma unroll 4
    for (int e = 0; e < 387; ++e) {
        const float pe = sc[e];
        const int p = e / 129, j = e % 129, D = p == 0 ? 1 : (p == 1 ? 4 : 16);
        int idx = self_idx - j * D; idx = idx < 0 ? 0 : idx;
        const float* vr;
        if (!smp) vr = P + (size_t)(b * SEQ + idx) * DIN + C_V + h * HD;
        else vr = j == 0 ? P + (size_t)r * DIN + C_V + h * HD : cv + (((size_t)(l * NS + b) * LC + idx) * NH + h) * HD;
        acc += pe * vr[lane];
    }
    const float z = P[(size_t)r * DIN + C_Z + h * HD + lane];
    MIX[(size_t)r * DM + h * HD + lane] = acc / den * siluf_(z);
}

__global__ void __launch_bounds__(256) nv_conv(const float* P, const float* st_a, const float* st_c, const float* aw, const float* ab, const float* ag, const float* alb,
                                               const float* cw, float* MIX, float* out, int l) {
    __shared__ float red[8];
    const int c = threadIdx.x, r = blockIdx.x, lane = c & 63, w = c >> 6;
    const bool smp = r >= NP; const int b = smp ? r - NP : r / SEQ, t = smp ? 0 : r % SEQ;
    auto U = [&](int rr) { const float* pr = P + (size_t)rr * DIN; return pr[C_AV + c] * sigmoidf_(pr[C_AG + c]); };
    auto UC = [&](int rr) { const float* pr = P + (size_t)rr * DIN; return pr[C_CC + c] * pr[C_CH + c]; };
    const float unew = U(r), ucnew = UC(r);
    float ca = ab[c];
    if (!smp) {
        for (int j = 0; j < 31; ++j) { const int tt = t - 30 + j; if (tt >= 0) ca += aw[j * 256 + c] * (j == 30 ? unew : U(b * SEQ + tt)); }
    } else {
        for (int j = 0; j < 30; ++j) ca += aw[j * 256 + c] * st_a[((size_t)(l * NS + b) * 30 + j) * 256 + c];
        ca += aw[30 * 256 + c] * unew;
    }
    float s = wave_sum(ca);
    if (lane == 0) red[w] = s;
    __syncthreads();
    const float mu = (red[0] + red[1] + red[2] + red[3]) * (1.f / 256.f);
    const float dlt = ca - mu;
    float s2 = wave_sum(dlt * dlt);
    if (lane == 0) red[4 + w] = s2;
    __syncthreads();
    const float var = (red[4] + red[5] + red[6] + red[7]) * (1.f / 256.f);
    const float ln = dlt * rsqrtf(var + EPS) * ag[c] + alb[c];
    const float* pr = P + (size_t)r * DIN;
    MIX[(size_t)r * DM + 512 + c] = siluf_(ln) * siluf_(pr[C_ZA + c]);
    float cs;
    if (!smp) cs = cw[2 * 256 + c] * ucnew + (t >= 1 ? cw[256 + c] * UC(r - 1) : 0.f) + (t >= 2 ? cw[c] * UC(r - 2) : 0.f);
    else cs = cw[2 * 256 + c] * ucnew + cw[256 + c] * st_c[((size_t)(l * NS + b) * 2 + 1) * 256 + c] + cw[c] * st_c[((size_t)(l * NS + b) * 2 + 0) * 256 + c];
    MIX[(size_t)r * DM + 768 + c] = pr[C_CB + c] * cs * siluf_(pr[C_ZC + c]);
    if (!smp) {
        if (t >= SEQ - 30) out[O_AP + ((size_t)(l * NB + b) * 30 + (t - (SEQ - 30))) * 256 + c] = unew;
        if (t >= SEQ - 2) out[O_CP + ((size_t)(l * NB + b) * 2 + (t - (SEQ - 2))) * 256 + c] = ucnew;
    } else {
        for (int i = 0; i < 29; ++i) out[O_AS + ((size_t)(l * NS + b) * 30 + i) * 256 + c] = st_a[((size_t)(l * NS + b) * 30 + i + 1) * 256 + c];
        out[O_AS + ((size_t)(l * NS + b) * 30 + 29) * 256 + c] = unew;
        out[O_CS + ((size_t)(l * NS + b) * 2 + 0) * 256 + c] = st_c[((size_t)(l * NS + b) * 2 + 1) * 256 + c];
        out[O_CS + ((size_t)(l * NS + b) * 2 + 1) * 256 + c] = ucnew;
    }
}

extern "C" void kernel_launch(void* const* d_in, const int* in_sizes, int n_in, void* d_out, int out_size, void* d_ws, size_t ws_size, hipStream_t stream) {
    const float* x_prompt = (const float*)d_in[0]; const float* x_sample = (const float*)d_in[1];
    const float* cache_k = (const float*)d_in[2]; const float* cache_v = (const float*)d_in[3];
    const float* st_a = (const float*)d_in[4]; const float* st_c = (const float*)d_in[5];
    const float* ln_g = (const float*)d_in[6]; const float* w_in = (const float*)d_in[7];
    const float* qg = (const float*)d_in[8]; const float* kg = (const float*)d_in[9];
    const float* aw = (const float*)d_in[10]; const float* ab = (const float*)d_in[11]; const float* ag = (const float*)d_in[12]; const float* alb = (const float*)d_in[13];
    const float* cw = (const float*)d_in[14]; const float* w_out = (const float*)d_in[15];
    float* out = (float*)d_out;
    char* ws = (char*)d_ws;
    constexpr size_t MiB = 1u << 20;
    float* XN = (float*)(ws);
    float* P = (float*)(ws + 130 * MiB);
    float* H1 = (float*)(ws + 612 * MiB);
    float* MIX = XN;

    hipLaunchKernelGGL(nv_cache_copy, dim3(2048), dim3(256), 0, stream, cache_k, cache_v, out);
    for (int l = 0; l < 2; ++l) {
        const float* hp = l == 0 ? x_prompt : H1; const float* hs = l == 0 ? x_sample : H1 + (size_t)NP * DM;
        hipLaunchKernelGGL(nv_rmsnorm, dim3(NR / 4), dim3(256), 0, stream, hp, hs, ln_g + l * DM, XN);
        hipLaunchKernelGGL(nv_gemm<false>, dim3(DIN / 64, (NR + 63) / 64), dim3(256), 0, stream, (const float*)XN, w_in + (size_t)l * DM * DIN, P, NR, DIN, DM, nullptr, nullptr);
        hipLaunchKernelGGL(nv_qkv_post, dim3((NR * NH * 3 + 3) / 4), dim3(256), 0, stream, P, qg + l * HD, kg + l * HD, out, l);
        hipLaunchKernelGGL(nv_attn, dim3(NR * NH / 4), dim3(256), 0, stream, (const float*)P, cache_k, cache_v, MIX, l);
        hipLaunchKernelGGL(nv_conv, dim3(NR), dim3(256), 0, stream, (const float*)P, st_a, st_c, aw + l * 31 * 256, ab + l * 256, ag + l * 256, alb + l * 256, cw + l * 3 * 256, MIX, out, l);
        float* dst = l == 0 ? H1 : out + O_Y;
        hipLaunchKernelGGL(nv_gemm<true>, dim3(DM / 64, (NR + 63) / 64), dim3(256), 0, stream, (const float*)MIX, w_out + (size_t)l * DM * DM, dst, NR, DM, DM, hp, hs);
    }
}
```

```cpp
#include <hip/hip_runtime.h>
#include <hip/hip_cooperative_groups.h>
#include <cstdint>
#include <cstdio>
namespace cg = cooperative_groups;

#ifndef DIAG
#define DIAG 0
#endif

constexpr int DM = 1024, NB = 4, SEQ = 8192, NP = NB * SEQ  , NS = 32, NR = NP + NS  , MPAD = NP + 256  ;
constexpr int DIN = 3840, NH = 8, HD = 64, LC = 2048, PAST = 16384;
constexpr float EPS = 1e-6f;
constexpr int C_Q = 0, C_K = 512, C_V = 1024, C_Z = 1536, C_AV = 2048, C_AG = 2304, C_ZA = 2560, C_CB = 2816, C_CC = 3072, C_CH = 3328, C_ZC = 3584;
constexpr size_t O_Y = 0, O_YS = 33554432, O_KP = 33587200, O_VP = 41975808, O_AP = 50364416, O_CP = 50425856,
                 O_KS = 50429952, O_VS = 117538816, O_AS = 184647680, O_CS = 185139200, O_END = 185171968;

__device__ __constant__ double ROPE_INV[32] = {
    1.0, 0.7498942093324559, 0.5623413251903491, 0.4216965034285822, 0.31622776601683794, 0.23713737056616552, 0.1778279410038923, 0.1333521432163324,
    0.1, 0.07498942093324558, 0.05623413251903491, 0.042169650342858224, 0.03162277660168379, 0.023713737056616554, 0.01778279410038923, 0.01333521432163324,
    0.01, 0.007498942093324558, 0.005623413251903491, 0.004216965034285823, 0.0031622776601683794, 0.0023713737056616554, 0.0017782794100389228, 0.001333521432163324,
    0.001, 0.0007498942093324559, 0.0005623413251903491, 0.00042169650342858224, 0.00031622776601683794, 0.00023713737056616554, 0.00017782794100389227, 0.0001333521432163324};

__device__ __forceinline__ float wave_sum(float v) {
#pragma unroll
    for (int o = 1; o < 64; o <<= 1) v += __shfl_xor(v, o);
    return v;
}
__device__ __forceinline__ float wave_max(float v) {
#pragma unroll
    for (int o = 1; o < 64; o <<= 1) v = fmaxf(v, __shfl_xor(v, o));
    return v;
}
__device__ __forceinline__ float sigmoidf_(float x) { return 1.0f / (1.0f + __expf(-x)); }
__device__ __forceinline__ float siluf_(float x) { return x * sigmoidf_(x); }
__device__ __forceinline__ void rope_cs(int pos, int i, float& c, float& s) {
    const double ang = (double)pos * ROPE_INV[i];
    const double n = rint(ang * 0.15915494309189535);
    const float r = (float)fma(-n, 6.283185307179586, ang);
    c = cosf(r); s = sinf(r);
}
#if DIAG
constexpr int R0 = 24576, NRN = NR - R0;
__global__ void __launch_bounds__(256) nv_rmsnorm(const float* xp, const float* xs, const float* g, float* xn) {
    const int lane = threadIdx.x & 63, r = R0 + blockIdx.x * 4 + (threadIdx.x >> 6);
    if (r >= NR) return;
    const float* x = r < NP ? xp + (size_t)r * DM : xs + (size_t)(r - NP) * DM;
    float4 v[4]; float ss = 0.f;
#pragma unroll
    for (int j = 0; j < 4; ++j) { v[j] = ((const float4*)x)[lane + 64 * j]; ss += v[j].x * v[j].x + v[j].y * v[j].y + v[j].z * v[j].z + v[j].w * v[j].w; }
    const float rstd = rsqrtf(wave_sum(ss) * (1.f / DM) + EPS);
#pragma unroll
    for (int j = 0; j < 4; ++j) {
        const float4 gg = ((const float4*)g)[lane + 64 * j];
        float4 o; o.x = v[j].x * rstd * gg.x; o.y = v[j].y * rstd * gg.y; o.z = v[j].z * rstd * gg.z; o.w = v[j].w * rstd * gg.w;
        ((float4*)(xn + (size_t)(r - R0) * DM))[lane + 64 * j] = o;
    }
}
template <bool RES> __global__ void __launch_bounds__(256) nv_gemm(const float* A, const float* B, float* C, int M, int N, int K, const float* rp, const float* rs) {
    __shared__ float As[16][68];
    __shared__ float Bs[16][64];
    const int tid = threadIdx.x, tx = tid & 15, ty = tid >> 4;
    const int m0 = blockIdx.y * 64, n0 = blockIdx.x * 64;
    float acc[4][4] = {};
    for (int k0 = 0; k0 < K; k0 += 16) {
        {
            const int row = tid >> 2, kk = (tid & 3) * 4, gr = m0 + row;
            float4 a = make_float4(0.f, 0.f, 0.f, 0.f);
            if (gr < M) a = *(const float4*)(A + (size_t)gr * K + k0 + kk);
            As[kk + 0][row] = a.x; As[kk + 1][row] = a.y; As[kk + 2][row] = a.z; As[kk + 3][row] = a.w;
            const int bk = tid >> 4, bn = (tid & 15) * 4;
            *(float4*)&Bs[bk][bn] = *(const float4*)(B + (size_t)(k0 + bk) * N + n0 + bn);
        }
        __syncthreads();
#pragma unroll
        for (int k = 0; k < 16; ++k) {
            const float4 a = *(const float4*)&As[k][ty * 4];
            const float4 b = *(const float4*)&Bs[k][tx * 4];
            const float av[4] = {a.x, a.y, a.z, a.w}, bv[4] = {b.x, b.y, b.z, b.w};
#pragma unroll
            for (int i = 0; i < 4; ++i)
#pragma unroll
                for (int j = 0; j < 4; ++j) acc[i][j] = fmaf(av[i], bv[j], acc[i][j]);
        }
        __syncthreads();
    }
#pragma unroll
    for (int i = 0; i < 4; ++i) {
        const int gr = m0 + ty * 4 + i;
        if (gr < M) {
            float4 o = make_float4(acc[i][0], acc[i][1], acc[i][2], acc[i][3]);
            if (RES) {
                const int rg = R0 + gr;
                const float* rr = rg < NP ? rp + (size_t)rg * N : rs + (size_t)(rg - NP) * N;
                const float4 x = *(const float4*)(rr + n0 + tx * 4);
                o.x += x.x; o.y += x.y; o.z += x.z; o.w += x.w;
            }
            *(float4*)(C + (size_t)gr * N + n0 + tx * 4) = o;
        }
    }
}
__global__ void __launch_bounds__(256) nv_qkv_post(float* P, const float* qg, const float* kg) {
    const int lane = threadIdx.x & 63;
    const long item = (long)blockIdx.x * 4 + (threadIdx.x >> 6);
    if (item >= (long)NRN * NH * 2) return;
    const int which = (int)(item % 2), h = (int)((item / 2) % NH), r = R0 + (int)(item / (2 * NH));
    const bool smp = r >= NP; const int t = smp ? 0 : r % SEQ, pos = smp ? PAST : t;
    float* p = P + (size_t)(r - R0) * DIN + which * 512 + h * HD + lane;
    float y = *p;
    const float ss = wave_sum(y * y);
    y = y * rsqrtf(ss * (1.f / HD) + EPS) * (which == 0 ? qg : kg)[lane];
    const float partner = __shfl_xor(y, 32);
    float c, s; rope_cs(pos, lane & 31, c, s);
    y = lane < 32 ? y * c - partner * s : y * c + partner * s;
    *p = y;
}
__global__ void __launch_bounds__(256) nv_attn(const float* P, const float* ck, const float* cv, float* MIX, int l) {
    __shared__ float sc_all[4][400];
    __shared__ float q_all[4][64];
    const int lane = threadIdx.x & 63, w = threadIdx.x >> 6;
    const int item = blockIdx.x * 4 + w;
    const int h = item % NH, r = R0 + item / NH;
    const bool smp = r >= NP; const int b = smp ? r - NP : r / SEQ, t = smp ? 0 : r % SEQ;
    float* sc = sc_all[w]; float* qs = q_all[w];
    qs[lane] = P[(size_t)(r - R0) * DIN + C_Q + h * HD + lane] * 0.125f;
    __builtin_amdgcn_s_waitcnt(0);
    const int self_idx = smp ? LC : t;
    float mloc = -INFINITY;
    for (int e = lane; e < 387; e += 64) {
        const int p = e / 129, j = e % 129, D = p == 0 ? 1 : (p == 1 ? 4 : 16);
        const int idx = self_idx - j * D;
        float s = -INFINITY;
        if (idx >= 0) {
            const float* kr;
            if (!smp) kr = P + (size_t)(b * SEQ + idx - R0) * DIN + C_K + h * HD;
            else kr = j == 0 ? P + (size_t)(r - R0) * DIN + C_K + h * HD : ck + (((size_t)(l * NS + b) * LC + idx) * NH + h) * HD;
            float a = 0.f;
#pragma unroll 4
            for (int d = 0; d < HD; d += 4) { const float4 kv = *(const float4*)(kr + d); a += qs[d] * kv.x + qs[d + 1] * kv.y + qs[d + 2] * kv.z + qs[d + 3] * kv.w; }
            s = a;
        }
        sc[e] = s; mloc = fmaxf(mloc, s);
    }
    const float m = wave_max(mloc);
    float lsum = 0.f;
    for (int e = lane; e < 387; e += 64) { const float ev = __expf(sc[e] - m); sc[e] = ev; lsum += ev; }
    const float den = wave_sum(lsum);
    __builtin_amdgcn_s_waitcnt(0);
    float acc = 0.f;
#pragma unroll 4
    for (int e = 0; e < 387; ++e) {
        const float pe = sc[e];
        const int p = e / 129, j = e % 129, D = p == 0 ? 1 : (p == 1 ? 4 : 16);
        int idx = self_idx - j * D; idx = idx < 0 ? 0 : idx;
        const float* vr;
        if (!smp) vr = P + (size_t)(b * SEQ + idx - R0) * DIN + C_V + h * HD;
        else vr = j == 0 ? P + (size_t)(r - R0) * DIN + C_V + h * HD : cv + (((size_t)(l * NS + b) * LC + idx) * NH + h) * HD;
        acc += pe * vr[lane];
    }
    const float z = P[(size_t)(r - R0) * DIN + C_Z + h * HD + lane];
    MIX[(size_t)(r - R0) * DM + h * HD + lane] = acc / den * siluf_(z);
}
__global__ void __launch_bounds__(256) nv_conv(const float* P, const float* st_a, const float* st_c, const float* aw, const float* ab, const float* ag, const float* alb,
                                               const float* cw, float* MIX, int l) {
    __shared__ float red[8];
    const int c = threadIdx.x, r = R0 + blockIdx.x, lane = c & 63, w = c >> 6;
    const bool smp = r >= NP; const int b = smp ? r - NP : r / SEQ, t = smp ? 0 : r % SEQ;
    auto U = [&](int rr) { const float* pr = P + (size_t)(rr - R0) * DIN; return pr[C_AV + c] * sigmoidf_(pr[C_AG + c]); };
    auto UC = [&](int rr) { const float* pr = P + (size_t)(rr - R0) * DIN; return pr[C_CC + c] * pr[C_CH + c]; };
    const float unew = U(r), ucnew = UC(r);
    float ca = ab[c];
    if (!smp) {
        for (int j = 0; j < 31; ++j) { const int tt = t - 30 + j; if (tt >= 0) ca += aw[j * 256 + c] * (j == 30 ? unew : U(b * SEQ + tt)); }
    } else {
        for (int j = 0; j < 30; ++j) ca += aw[j * 256 + c] * st_a[((size_t)(l * NS + b) * 30 + j) * 256 + c];
        ca += aw[30 * 256 + c] * unew;
    }
    float s = wave_sum(ca);
    if (lane == 0) red[w] = s;
    __syncthreads();
    const float mu = (red[0] + red[1] + red[2] + red[3]) * (1.f / 256.f);
    const float dlt = ca - mu;
    float s2 = wave_sum(dlt * dlt);
    if (lane == 0) red[4 + w] = s2;
    __syncthreads();
    const float var = (red[4] + red[5] + red[6] + red[7]) * (1.f / 256.f);
    const float ln = dlt * rsqrtf(var + EPS) * ag[c] + alb[c];
    const float* pr = P + (size_t)(r - R0) * DIN;
    MIX[(size_t)(r - R0) * DM + 512 + c] = siluf_(ln) * siluf_(pr[C_ZA + c]);
    float cs;
    if (!smp) cs = cw[2 * 256 + c] * ucnew + (t >= 1 ? cw[256 + c] * UC(r - 1) : 0.f) + (t >= 2 ? cw[c] * UC(r - 2) : 0.f);
    else cs = cw[2 * 256 + c] * ucnew + cw[256 + c] * st_c[((size_t)(l * NS + b) * 2 + 1) * 256 + c] + cw[c] * st_c[((size_t)(l * NS + b) * 2 + 0) * 256 + c];
    MIX[(size_t)(r - R0) * DM + 768 + c] = pr[C_CB + c] * cs * siluf_(pr[C_ZC + c]);
}
#endif
#define LAS __attribute__((address_space(3)))
typedef unsigned short bf16_t;
typedef short bf16x8 __attribute__((ext_vector_type(8)));
typedef float f32x4 __attribute__((ext_vector_type(4)));
typedef float f32x16 __attribute__((ext_vector_type(16)));
typedef unsigned u32x4 __attribute__((ext_vector_type(4)));
typedef unsigned u32x2 __attribute__((ext_vector_type(2)));
typedef short v4i16_t __attribute__((ext_vector_type(4)));

constexpr size_t MiB = 1u << 20;
constexpr size_t WS_WIN = 0, WS_WOUT = 15 * MiB, WS_ROPE = 19 * MiB, WS_SSQ = 22 * MiB, WS_QS = 25 * MiB, WS_PL = 26 * MiB, WS_XB = 32 * MiB, WS_AMIX = 97 * MiB,
                 WS_QB = 162 * MiB, WS_KB = 194 * MiB, WS_VB = 226 * MiB, WS_ZB = 258 * MiB, WS_UB = 291 * MiB, WS_ZA = 308 * MiB, WS_UC = 325 * MiB, WS_GC = 342 * MiB,
                 WS_PO = 359 * MiB, WS_H1 = 455 * MiB, WS_END = 584 * MiB;
constexpr size_t WS_NXN = 600 * MiB, WS_NP = 633 * MiB, WS_NH1 = 754 * MiB, WS_ERR = 787 * MiB;
constexpr int NTHR = 512, NWAVE = 8, LDS_BYTES = 135168;
constexpr float LOG2E = 1.4426950408889634f;
constexpr int N_PHASES = 9;

__device__ __forceinline__ unsigned f2bf(float f) { unsigned u = __builtin_bit_cast(unsigned, f); return (u + 0x7fffu + ((u >> 16) & 1u)) >> 16; }
__device__ __forceinline__ unsigned pk2(float lo, float hi) { return f2bf(lo) | (f2bf(hi) << 16); }
__device__ __forceinline__ float bf2f(unsigned v) { return __builtin_bit_cast(float, v << 16); }
__device__ __forceinline__ float bflo(unsigned w) { return __builtin_bit_cast(float, w << 16); }
__device__ __forceinline__ float bfhi(unsigned w) { return __builtin_bit_cast(float, w & 0xffff0000u); }
__device__ __forceinline__ u32x4 pack8(const float* v) { u32x4 o; o.x = pk2(v[0], v[1]); o.y = pk2(v[2], v[3]); o.z = pk2(v[4], v[5]); o.w = pk2(v[6], v[7]); return o; }

struct Params { const float* in[16]; float* out; unsigned char* ws; int ph_lo, ph_hi; };

struct Frame {
    LAS unsigned char* lds;
    int tid, lane, wave, G, bid;
    const float *x_prompt, *x_sample, *cache_k, *cache_v, *st_a, *st_c, *ln_g, *w_in, *qg, *kg, *aw, *ab, *ag, *alb, *cw, *w_out;
    float* out;
    bf16_t *WinT, *WoutT, *XB, *AMIX, *QB, *KB, *VB, *ZB, *UB, *ZA, *UC, *GC, *PO;
    float2* ROPE; float* SSQ; float* QS; float2* PL; float* H1;
};

__host__ __device__ __forceinline__ int src_col(int np) {
    const int pn = np >> 8, ct = np & 255, bj = ct >> 7, wc = (ct >> 5) & 3, c = ct & 31;
    if (pn < 6) return (pn >> 1) * 512 + (4 * (pn & 1) + wc) * 64 + 32 * bj + c;
    if (pn < 8) return C_Z + 256 * (pn - 6) + ct;
    if (pn < 10) return (bj == 0 ? C_AV : C_AG) + 128 * (pn - 8) + (ct & 127);
    if (pn == 10) return C_ZA + ct;
    if (pn < 13) return (bj == 0 ? C_CC : C_CH) + 128 * (pn - 11) + (ct & 127);
    return (bj == 0 ? C_CB : C_ZC) + 128 * (pn - 13) + (ct & 127);
}
namespace pg8 {
#define PG8_LAS __attribute__((address_space(3)))
typedef unsigned short bf16_t;
typedef short bf16x8 __attribute__((ext_vector_type(8)));
typedef float f32x4 __attribute__((ext_vector_type(4)));
typedef unsigned u32x4 __attribute__((ext_vector_type(4)));
constexpr int BM = 256, BK = 64, HALF = 128, HTB = HALF * BK * 2  , STAGE_BYTES = 8 * HTB, NXCD = 8, WGM = 8;

__host__ __device__ __forceinline__ int lds_byte(int r, int c) { const int st = (r >> 4) * 2 + (c >> 5), rr = r & 15, cc = c & 31, ob = rr * 64 + cc * 2; return st * 1024 + (ob ^ (((ob >> 9) & 1) << 5)); }
__host__ __device__ __forceinline__ void stage_rc(int b, int& R, int& C) { const int st = b / 1024, sb = b % 1024, swz = sb ^ (((sb >> 9) & 1) << 5); R = (st >> 1) * 16 + swz / 64; C = (st & 1) * 32 + (swz % 64) / 2; }
__host__ __device__ __forceinline__ int perm32(int rho) { const int n = rho >> 4, i = rho & 15; return 8 * (i >> 2) + 4 * n + (i & 3); }

struct Unit { int pm, pn; };
struct Gemm { const bf16_t* A; const bf16_t* Bt; int M, N, K; };

struct StaticOrder {
    int nM, nN, nwg, G, c;
    __host__ __device__ void init(int M, int N, int G_, int c_) { nM = M / BM; nN = N / BM; nwg = nM * nN; G = G_; c = c_; }
    __host__ __device__ bool next(int i, Unit& u) const {
        const long L = (long)i * G + c; if (L >= nwg) return false;
        int wgid = (int)L; { const int q = nwg / NXCD, r = nwg % NXCD, xcd = wgid % NXCD, off = wgid / NXCD; wgid = (xcd < r ? xcd * (q + 1) : r * (q + 1) + (xcd - r) * q) + off; }
        const int nig = WGM * nN, gid = wgid / nig, fm = gid * WGM, gsz = (nM - fm) < WGM ? (nM - fm) : WGM;
        u.pm = fm + ((wgid % nig) % gsz); u.pn = (wgid % nig) / gsz; return true;
    }
    __device__ __forceinline__ void a_ready(const Unit&) const {}
    __device__ __forceinline__ void done(const Unit&) const {}
};

template <class Epi, class Sched, bool ALIGN_EPI = false, bool SP2 = false>
__device__ __forceinline__ void gemm_phase(PG8_LAS unsigned char* lds, const Gemm g, const Sched& S, const Epi& E) {
    int tid_l = threadIdx.x; asm volatile("" : "+v"(tid_l));
    const int tid = tid_l, wid = __builtin_amdgcn_readfirstlane(tid >> 6), lane = tid & 63, wr = wid >> 2, wc = wid & 3, fr = lane & 15, fq = lane >> 4;
    const int K = g.K, nt = K / BK;
    unsigned voffA[2], voffB[2];
#pragma unroll
    for (int i = 0; i < 2; ++i) { int R, C; stage_rc(tid * 16 + i * 8192, R, C); const int Rb = Epi::PERM ? ((R & ~31) + perm32(R & 31)) : R;
        voffA[i] = (unsigned)(R * K + C) * 2u; voffB[i] = (unsigned)(Rb * K + C) * 2u; }
    const size_t kstep = (size_t)(BK * 2);
    const size_t hstep = (size_t)HALF * K * 2;
    const size_t tstep = 2 * hstep;
    const unsigned ldsw = (unsigned)wid * 1024u;
    const int aoff = lds_byte(wr * 64 + fr, fq * 8), boff = lds_byte(wc * 32 + fr, fq * 8);
#define PG8_SA(b, h) (((b) * 2 + (h)) * HTB)
#define PG8_SB(b, h) ((4 + (b) * 2 + (h)) * HTB)
#define PG8_STAGE(bufoff, gbase, voff) do { _Pragma("unroll") for (int _i = 0; _i < 2; ++_i) \
        __builtin_amdgcn_global_load_lds((const unsigned*)((const char*)(gbase) + (voff)[_i]), (PG8_LAS unsigned*)(lds + (bufoff) + ldsw + _i * 8192), 16, 0, 0); } while (0)
#define PG8_LDA(dst, b, h) do { _Pragma("unroll") for (int m = 0; m < 4; ++m) _Pragma("unroll") for (int k = 0; k < 2; ++k) dst[m][k] = *(const PG8_LAS bf16x8*)(lds + PG8_SA(b, h) + aoff + m * 2048 + k * 1024); } while (0)
#define PG8_LDB(dst, b, h) do { _Pragma("unroll") for (int n = 0; n < 2; ++n) _Pragma("unroll") for (int k = 0; k < 2; ++k) dst[n][k] = *(const PG8_LAS bf16x8*)(lds + PG8_SB(b, h) + boff + n * 2048 + k * 1024); } while (0)
#define PG8_MMA(ai, bj, At, Bt) do { __builtin_amdgcn_s_setprio(1); _Pragma("unroll") for (int m = 0; m < 4; ++m) _Pragma("unroll") for (int n = 0; n < 2; ++n) _Pragma("unroll") for (int k = 0; k < 2; ++k) \
        acc[ai][bj][m][n] = __builtin_amdgcn_mfma_f32_16x16x32_bf16(Bt[n][k], At[m][k], acc[ai][bj][m][n], 0, 0, 0); __builtin_amdgcn_s_setprio(0); } while (0)
#define PG8_WAIT_V(n) asm volatile("s_waitcnt vmcnt(" #n ")" ::: "memory")
#define PG8_WAIT_L(n) asm volatile("s_waitcnt lgkmcnt(" #n ")" ::: "memory")
#define PG8_BAR __builtin_amdgcn_s_barrier()
#define PG8_SCHED __builtin_amdgcn_sched_barrier(0)
    Unit cur, nxt; int ui = 0;
    if (!S.next(0, cur)) return;
    f32x4 acc[2][2][4][2];
#pragma unroll
    for (int a = 0; a < 2; ++a)
#pragma unroll
        for (int b = 0; b < 2; ++b)
#pragma unroll
            for (int m = 0; m < 4; ++m)
#pragma unroll
                for (int n = 0; n < 2; ++n) acc[a][b][m][n] = (f32x4){0.f, 0.f, 0.f, 0.f};
    bf16x8 At[4][2], B0[2][2], B1[2][2];
    const char* cA = (const char*)g.A + (size_t)cur.pm * tstep; const char* cB = (const char*)g.Bt + (size_t)cur.pn * tstep;
    S.a_ready(cur);
    if constexpr (SP2) {
        PG8_STAGE(PG8_SB(0, 0), cB, voffB); PG8_STAGE(PG8_SB(0, 1), cB + hstep, voffB); PG8_STAGE(PG8_SA(0, 0), cA, voffA); PG8_STAGE(PG8_SA(0, 1), cA + hstep, voffA);
        if (wr == 1) PG8_BAR;
        PG8_WAIT_V(2); PG8_BAR;
        PG8_STAGE(PG8_SB(1, 0), cB + kstep, voffB); PG8_STAGE(PG8_SA(1, 0), cA + kstep, voffA); PG8_STAGE(PG8_SB(1, 1), cB + hstep + kstep, voffB);
        PG8_WAIT_V(6); PG8_BAR;
    } else {
        PG8_STAGE(PG8_SB(0, 0), cB, voffB); PG8_STAGE(PG8_SA(0, 0), cA, voffA); PG8_STAGE(PG8_SB(0, 1), cB + hstep, voffB); PG8_STAGE(PG8_SA(0, 1), cA + hstep, voffA);
        if (wr == 1) PG8_BAR;
        PG8_WAIT_V(4); PG8_BAR;
        PG8_STAGE(PG8_SB(1, 0), cB + kstep, voffB); PG8_STAGE(PG8_SA(1, 0), cA + kstep, voffA); PG8_STAGE(PG8_SB(1, 1), cB + hstep + kstep, voffB);
        PG8_WAIT_V(6); PG8_BAR;
    }
    for (;;) {
        const bool has_next = S.next(ui + 1, nxt);
        const char* nA = has_next ? (const char*)g.A + (size_t)nxt.pm * tstep : cA; const char* nB = has_next ? (const char*)g.Bt + (size_t)nxt.pn * tstep : cB;
        for (int t = 0; t < nt; t += 2) {
            const bool last = (t == nt - 2);
            const char* a1 = cA + (size_t)(t + 1) * kstep;
            const char* a2 = last ? nA : cA + (size_t)(t + 2) * kstep; const char* b2 = last ? nB : cB + (size_t)(t + 2) * kstep;
            const char* a3 = a2 + kstep; const char* b3 = b2 + kstep;
            if (last && has_next) S.a_ready(nxt);
            if constexpr (SP2) {
            PG8_LDB(B0, 0, 0); PG8_LDB(B1, 0, 1); PG8_SCHED; PG8_LDA(At, 0, 0); PG8_STAGE(PG8_SA(1, 1), a1 + hstep, voffA);
            PG8_WAIT_V(8); PG8_WAIT_L(0); PG8_BAR; PG8_MMA(0, 0, At, B0); PG8_MMA(0, 1, At, B1); PG8_BAR; PG8_SCHED;
            PG8_LDA(At, 0, 1); PG8_STAGE(PG8_SB(0, 0), b2, voffB); PG8_STAGE(PG8_SB(0, 1), b2 + hstep, voffB); PG8_STAGE(PG8_SA(0, 0), a2, voffA);
            PG8_WAIT_V(8); PG8_WAIT_L(0); PG8_BAR; PG8_MMA(1, 0, At, B0); PG8_MMA(1, 1, At, B1); PG8_BAR; PG8_SCHED;
            PG8_LDB(B0, 1, 0); PG8_LDB(B1, 1, 1); PG8_SCHED; PG8_LDA(At, 1, 0); PG8_STAGE(PG8_SA(0, 1), a2 + hstep, voffA);
            PG8_WAIT_V(8); PG8_WAIT_L(0); PG8_BAR; PG8_MMA(0, 0, At, B0); PG8_MMA(0, 1, At, B1); PG8_BAR; PG8_SCHED;
            PG8_LDA(At, 1, 1); PG8_STAGE(PG8_SB(1, 0), b3, voffB); PG8_STAGE(PG8_SB(1, 1), b3 + hstep, voffB); PG8_STAGE(PG8_SA(1, 0), a3, voffA);
            PG8_WAIT_V(8); PG8_WAIT_L(0); PG8_BAR; PG8_MMA(1, 0, At, B0); PG8_MMA(1, 1, At, B1); PG8_BAR; PG8_SCHED;
            } else {
            PG8_LDB(B0, 0, 0); PG8_SCHED; PG8_LDA(At, 0, 0); PG8_STAGE(PG8_SA(1, 1), a1 + hstep, voffA);
            PG8_WAIT_L(8); PG8_BAR; PG8_WAIT_L(0); PG8_MMA(0, 0, At, B0); PG8_BAR; PG8_SCHED;
            PG8_LDB(B1, 0, 1); PG8_STAGE(PG8_SB(0, 0), b2, voffB);
            PG8_BAR; PG8_WAIT_L(0); PG8_MMA(0, 1, At, B1); PG8_BAR;
            PG8_LDA(At, 0, 1); PG8_STAGE(PG8_SA(0, 0), a2, voffA);
            PG8_BAR; PG8_WAIT_L(0); PG8_MMA(1, 0, At, B0); PG8_BAR; PG8_SCHED;
            PG8_STAGE(PG8_SB(0, 1), b2 + hstep, voffB);
            PG8_WAIT_V(6); PG8_BAR; PG8_MMA(1, 1, At, B1); PG8_BAR;
            PG8_LDB(B0, 1, 0); PG8_SCHED; PG8_LDA(At, 1, 0); PG8_STAGE(PG8_SA(0, 1), a2 + hstep, voffA);
            PG8_WAIT_L(8); PG8_BAR; PG8_WAIT_L(0); PG8_MMA(0, 0, At, B0); PG8_BAR; PG8_SCHED;
            PG8_LDB(B1, 1, 1); PG8_STAGE(PG8_SB(1, 0), b3, voffB);
            PG8_BAR; PG8_WAIT_L(0); PG8_MMA(0, 1, At, B1); PG8_BAR;
            PG8_LDA(At, 1, 1); PG8_STAGE(PG8_SA(1, 0), a3, voffA);
            PG8_BAR; PG8_WAIT_L(0); PG8_MMA(1, 0, At, B0); PG8_BAR; PG8_SCHED;
            PG8_STAGE(PG8_SB(1, 1), b3 + hstep, voffB);
            PG8_WAIT_V(6); PG8_BAR; PG8_MMA(1, 1, At, B1); PG8_BAR;
            }
        }
        if constexpr (ALIGN_EPI) { if (wr == 0) PG8_BAR; }
        if constexpr (!Epi::AFTER_DRAIN) { E(acc, cur, wr, wc, fr, fq); S.done(cur); }
        if (!has_next) break;
#pragma unroll
        for (int a = 0; a < 2; ++a)
#pragma unroll
            for (int b = 0; b < 2; ++b)
#pragma unroll
                for (int m = 0; m < 4; ++m)
#pragma unroll
                    for (int n = 0; n < 2; ++n) acc[a][b][m][n] = (f32x4){0.f, 0.f, 0.f, 0.f};
        cur = nxt; cA = nA; cB = nB; ++ui;
        if constexpr (ALIGN_EPI) { if (wr == 1) PG8_BAR; }
    }
    PG8_WAIT_V(0);
    if constexpr (!ALIGN_EPI) { if (wr == 0) PG8_BAR; }
    PG8_BAR;
    if constexpr (Epi::AFTER_DRAIN) { E.fused(acc, cur, wr, wc, fr, fq, lds, wid, lane); S.done(cur); }
#undef PG8_SA
#undef PG8_SB
#undef PG8_STAGE
#undef PG8_LDA
#undef PG8_LDB
#undef PG8_MMA
#undef PG8_WAIT_V
#undef PG8_WAIT_L
#undef PG8_BAR
#undef PG8_SCHED
}
}
struct EpiIn {
    static constexpr bool PERM = true, AFTER_DRAIN = false;
    unsigned char* ws; float* out; const float* qg; const float* kg; int l;
    __device__ __forceinline__ void operator()(const f32x4 (&acc)[2][2][4][2], const pg8::Unit& u, int wr, int wc, int fr, int fq) const {
        const int pn = u.pn, c8 = 8 * fq;
        const float* ssq = (const float*)(ws + WS_SSQ); const float2* rope = (const float2*)(ws + WS_ROPE); float* QS = (float*)(ws + WS_QS);
        bf16_t* QB = (bf16_t*)(ws + WS_QB); bf16_t* KB = (bf16_t*)(ws + WS_KB); bf16_t* VB = (bf16_t*)(ws + WS_VB); bf16_t* ZB = (bf16_t*)(ws + WS_ZB);
        bf16_t* UB = (bf16_t*)(ws + WS_UB); bf16_t* ZA = (bf16_t*)(ws + WS_ZA); bf16_t* UC = (bf16_t*)(ws + WS_UC); bf16_t* GC = (bf16_t*)(ws + WS_GC);
#pragma unroll
        for (int ai = 0; ai < 2; ++ai)
#pragma unroll
            for (int m = 0; m < 4; ++m) {
                const int r = u.pm * 256 + ai * 128 + wr * 64 + m * 16 + fr;
                if (r < NR) {
                    const f32x4* sp = (const f32x4*)(ssq + (size_t)r * 16);
                    const f32x4 s0 = sp[0], s1 = sp[1], s2 = sp[2], s3 = sp[3];
                    const float ssr = ((s0[0] + s0[1]) + (s0[2] + s0[3])) + ((s1[0] + s1[1]) + (s1[2] + s1[3])) + ((s2[0] + s2[1]) + (s2[2] + s2[3])) + ((s3[0] + s3[1]) + (s3[2] + s3[3]));
                    const float rstd = rsqrtf(ssr * (1.f / DM) + EPS);
                    float v0[8], v1[8];
#pragma unroll
                    for (int n = 0; n < 2; ++n)
#pragma unroll
                        for (int j = 0; j < 4; ++j) { v0[4 * n + j] = acc[ai][0][m][n][j] * rstd; v1[4 * n + j] = acc[ai][1][m][n][j] * rstd; }
                    const bool smp = r >= NP; const int b = smp ? r - NP : r >> 13, t = smp ? 0 : r & (SEQ - 1);
                    if (pn < 6) {
                        const int head = 4 * (pn & 1) + wc;
                        if (pn < 4) {
                            float sh = 0.f;
#pragma unroll
                            for (int i = 0; i < 8; ++i) sh += v0[i] * v0[i] + v1[i] * v1[i];
                            sh += __shfl_xor(sh, 16); sh += __shfl_xor(sh, 32);
                            const float nrm = rsqrtf(sh * (1.f / HD) + EPS);
                            const float* gg = pn < 2 ? qg : kg;
                            const f32x4 ga0 = *(const f32x4*)(gg + c8), ga1 = *(const f32x4*)(gg + c8 + 4), gb0 = *(const f32x4*)(gg + 32 + c8), gb1 = *(const f32x4*)(gg + 32 + c8 + 4);
                            const f32x4* rp = (const f32x4*)(rope + (size_t)(smp ? SEQ : t) * 32 + c8);
                            const f32x4 r0 = rp[0], r1 = rp[1], r2 = rp[2], r3 = rp[3];
                            const float cs[8] = {r0[0], r0[2], r1[0], r1[2], r2[0], r2[2], r3[0], r3[2]}, sn[8] = {r0[1], r0[3], r1[1], r1[3], r2[1], r2[3], r3[1], r3[3]};
                            const float ga[8] = {ga0[0], ga0[1], ga0[2], ga0[3], ga1[0], ga1[1], ga1[2], ga1[3]}, gb[8] = {gb0[0], gb0[1], gb0[2], gb0[3], gb1[0], gb1[1], gb1[2], gb1[3]};
                            const float qscale = pn < 2 ? (smp ? 0.125f : 0.125f * LOG2E) : 1.0f;
#pragma unroll
                            for (int i = 0; i < 8; ++i) {
                                const float x1 = v0[i] * nrm * ga[i], x2 = v1[i] * nrm * gb[i];
                                v0[i] = (x1 * cs[i] - x2 * sn[i]) * qscale; v1[i] = (x2 * cs[i] + x1 * sn[i]) * qscale;
                            }
                        }
                        if (smp) {
                            if (pn < 2) {
                                float* q = QS + (size_t)(b * NH + head) * HD + c8;
                                *(f32x4*)(q) = (f32x4){v0[0], v0[1], v0[2], v0[3]}; *(f32x4*)(q + 4) = (f32x4){v0[4], v0[5], v0[6], v0[7]};
                                *(f32x4*)(q + 32) = (f32x4){v1[0], v1[1], v1[2], v1[3]}; *(f32x4*)(q + 36) = (f32x4){v1[4], v1[5], v1[6], v1[7]};
                            } else {
                                float* o = out + (pn < 4 ? O_KS : O_VS) + (((size_t)(l * NS + b) * LC + (LC - 1)) * NH + head) * HD + c8;
                                *(f32x4*)(o) = (f32x4){v0[0], v0[1], v0[2], v0[3]}; *(f32x4*)(o + 4) = (f32x4){v0[4], v0[5], v0[6], v0[7]};
                                *(f32x4*)(o + 32) = (f32x4){v1[0], v1[1], v1[2], v1[3]}; *(f32x4*)(o + 36) = (f32x4){v1[4], v1[5], v1[6], v1[7]};
                            }
                        } else {
                            bf16_t* dst = (pn < 2 ? QB : (pn < 4 ? KB : VB)) + ((size_t)(b * NH + head) * SEQ + t) * HD + c8;
                            *(u32x4*)(dst) = pack8(v0); *(u32x4*)(dst + 32) = pack8(v1);
                            if (pn >= 2 && t >= SEQ - LC) {
                                float* o = out + (pn < 4 ? O_KP : O_VP) + (((size_t)(l * NB + b) * LC + (t - (SEQ - LC))) * NH + head) * HD + c8;
                                *(f32x4*)(o) = (f32x4){v0[0], v0[1], v0[2], v0[3]}; *(f32x4*)(o + 4) = (f32x4){v0[4], v0[5], v0[6], v0[7]};
                                *(f32x4*)(o + 32) = (f32x4){v1[0], v1[1], v1[2], v1[3]}; *(f32x4*)(o + 36) = (f32x4){v1[4], v1[5], v1[6], v1[7]};
                            }
                        }
                    } else if (pn < 8) {
                        bf16_t* dst = ZB + (size_t)r * 512 + 256 * (pn - 6) + 32 * wc + c8;
#pragma unroll
                        for (int i = 0; i < 8; ++i) { v0[i] = siluf_(v0[i]); v1[i] = siluf_(v1[i]); }
                        *(u32x4*)(dst) = pack8(v0); *(u32x4*)(dst + 128) = pack8(v1);
                    } else if (pn == 10) {
                        bf16_t* dst = ZA + (size_t)r * 256 + 32 * wc + c8;
#pragma unroll
                        for (int i = 0; i < 8; ++i) { v0[i] = siluf_(v0[i]); v1[i] = siluf_(v1[i]); }
                        *(u32x4*)(dst) = pack8(v0); *(u32x4*)(dst + 128) = pack8(v1);
                    } else {
                        const int kind = pn < 10 ? 0 : (pn < 13 ? 1 : 2);
                        const int ch = 128 * (pn - (kind == 0 ? 8 : (kind == 1 ? 11 : 13))) + 32 * wc + c8;
#pragma unroll
                        for (int i = 0; i < 8; ++i) v0[i] = kind == 0 ? v0[i] * sigmoidf_(v1[i]) : (kind == 1 ? v0[i] * v1[i] : v0[i] * siluf_(v1[i]));
                        bf16_t* dst = (kind == 0 ? UB : (kind == 1 ? UC : GC)) + (size_t)r * 256 + ch;
                        *(u32x4*)(dst) = pack8(v0);
                        if (kind < 2) {
                            float* o = nullptr;
                            if (kind == 0) { if (smp) o = out + O_AS + ((size_t)(l * NS + b) * 30 + 29) * 256 + ch; else if (t >= SEQ - 30) o = out + O_AP + ((size_t)(l * NB + b) * 30 + (t - (SEQ - 30))) * 256 + ch; }
                            else { if (smp) o = out + O_CS + ((size_t)(l * NS + b) * 2 + 1) * 256 + ch; else if (t >= SEQ - 2) o = out + O_CP + ((size_t)(l * NB + b) * 2 + (t - (SEQ - 2))) * 256 + ch; }
                            if (o) { *(f32x4*)(o) = (f32x4){v0[0], v0[1], v0[2], v0[3]}; *(f32x4*)(o + 4) = (f32x4){v0[4], v0[5], v0[6], v0[7]}; }
                        }
                    }
                }
            }
    }
};

struct EpiOut {
    static constexpr bool PERM = true, AFTER_DRAIN = false;
    const float* res; float* dst; unsigned char* ws; int l;
    __device__ __forceinline__ void operator()(const f32x4 (&acc)[2][2][4][2], const pg8::Unit& u, int wr, int wc, int fr, int fq) const {
        bf16_t* XB = (bf16_t*)(ws + WS_XB); float* ssq = (float*)(ws + WS_SSQ);
#pragma unroll
        for (int ai = 0; ai < 2; ++ai)
#pragma unroll
            for (int m = 0; m < 4; ++m) {
                const int r = u.pm * 256 + ai * 128 + wr * 64 + m * 16 + fr;
                const size_t off = (size_t)r * DM + u.pn * 256 + 32 * wc + 8 * fq;
                float ss = 0.f;
#pragma unroll
                for (int bj = 0; bj < 2; ++bj) {
                    const f32x4 x0 = *(const f32x4*)(res + off + 128 * bj), x1 = *(const f32x4*)(res + off + 128 * bj + 4);
                    const f32x4 y0 = x0 + acc[ai][bj][m][0], y1 = x1 + acc[ai][bj][m][1];
                    *(f32x4*)(dst + off + 128 * bj) = y0; *(f32x4*)(dst + off + 128 * bj + 4) = y1;
                    if (l == 0) {
                        const float yv[8] = {y0[0], y0[1], y0[2], y0[3], y1[0], y1[1], y1[2], y1[3]};
                        *(u32x4*)(XB + off + 128 * bj) = pack8(yv);
#pragma unroll
                        for (int i = 0; i < 8; ++i) ss += yv[i] * yv[i];
                    }
                }
                if (l == 0) {
                    ss += __shfl_xor(ss, 16); ss += __shfl_xor(ss, 32);
                    if (fq == 0) ssq[(size_t)r * 16 + u.pn * 4 + wc] = ss;
                }
            }
    }
};
#define LDS_WAIT() asm volatile("s_waitcnt lgkmcnt(0)" ::: "memory")
#define VM_WAIT() asm volatile("s_waitcnt vmcnt(0)" ::: "memory")

__device__ __forceinline__ void p0_transpose_item(const float* W, int N, int col0, const float* gk, bf16_t* dst, int k0, LAS float* scr, int lane) {
#pragma unroll 8
    for (int i = 0; i < 32; ++i) { const int kk = 2 * i + (lane >> 5); float w = W[(size_t)(k0 + kk) * N + col0 + (lane & 31)]; if (gk) w *= gk[k0 + kk]; scr[kk * 33 + (lane & 31)] = w; }
    LDS_WAIT(); asm volatile("" ::: "memory");
    const int c = lane & 7;
#pragma unroll
    for (int j = 0; j < 4; ++j) { const int n = (lane >> 3) + 8 * j; const LAS float* s = scr + (8 * c) * 33 + n;
        u32x4 o; o.x = pk2(s[0 * 33], s[1 * 33]); o.y = pk2(s[2 * 33], s[3 * 33]); o.z = pk2(s[4 * 33], s[5 * 33]); o.w = pk2(s[6 * 33], s[7 * 33]);
        *(u32x4*)(dst + (size_t)n * DM + k0 + 8 * c) = o; }
    LDS_WAIT(); asm volatile("" ::: "memory");
}

__device__ __forceinline__ void p0_prologue(Frame& F) {
    const int gw = F.bid * NWAVE + F.wave, NGW = F.G * NWAVE, lane = F.lane;
    LAS float* scr = (LAS float*)(F.lds + F.wave * 8448);
    for (int it = gw; it < 2 * 2432; it += NGW) {
        const int l = it / 2432; int r = it % 2432;
        if (r < 1920) { const int kb = r / 120, ng = r % 120;
            p0_transpose_item(F.w_in + (size_t)l * DM * DIN, DIN, src_col(ng * 32), F.ln_g + l * DM, F.WinT + ((size_t)l * DIN + ng * 32) * DM, kb * 64, scr, lane); }
        else { r -= 1920; const int kb = r / 32, ng = r % 32;
            p0_transpose_item(F.w_out + (size_t)l * DM * DM, DM, ng * 32, nullptr, F.WoutT + ((size_t)l * DM + ng * 32) * DM, kb * 64, scr, lane); }
    }
    const int gt = F.bid * NTHR + F.tid, NGT = F.G * NTHR;
    for (int idx = gt; idx < (SEQ + 1) * 32; idx += NGT) { const int pos = idx >> 5; float c, s; rope_cs(pos == SEQ ? PAST : pos, idx & 31, c, s); F.ROPE[idx] = make_float2(c, s); }
    for (int r = gw; r < MPAD; r += NGW) {
        f32x4 v[4]; float ss = 0.f;
        if (r < NR) { const f32x4* xr = (const f32x4*)(r < NP ? F.x_prompt + (size_t)r * DM : F.x_sample + (size_t)(r - NP) * DM) + lane;
#pragma unroll
            for (int j = 0; j < 4; ++j) { v[j] = xr[64 * j]; ss += (v[j][0] * v[j][0] + v[j][1] * v[j][1]) + (v[j][2] * v[j][2] + v[j][3] * v[j][3]); } }
        else {
#pragma unroll
            for (int j = 0; j < 4; ++j) v[j] = (f32x4){0.f, 0.f, 0.f, 0.f}; }
        ss = wave_sum(ss);
        u32x2* o8 = (u32x2*)(F.XB + (size_t)r * DM) + lane;
#pragma unroll
        for (int j = 0; j < 4; ++j) { u32x2 w; w.x = pk2(v[j][0], v[j][1]); w.y = pk2(v[j][2], v[j][3]); o8[64 * j] = w; }
        if (lane < 16) F.SSQ[(size_t)r * 16 + lane] = lane == 0 ? ss : 0.f;
    }
    {
        const size_t per = (size_t)LC * 512 / 4, tot = 64 * per;
        const f32x4* ck = (const f32x4*)F.cache_k; const f32x4* cv = (const f32x4*)F.cache_v;
        f32x4* ok = (f32x4*)(F.out + O_KS); f32x4* ov = (f32x4*)(F.out + O_VS);
        for (size_t i = gt; i < tot; i += (size_t)NGT * 4) {
            f32x4 a[4], b[4]; bool ok_[4];
#pragma unroll
            for (int u = 0; u < 4; ++u) { const size_t ii = i + (size_t)u * NGT; ok_[u] = ii < tot && (ii % per) / 128 < LC - 1; if (ok_[u]) { a[u] = ck[ii + 128]; b[u] = cv[ii + 128]; } }
#pragma unroll
            for (int u = 0; u < 4; ++u) { const size_t ii = i + (size_t)u * NGT; if (ok_[u]) { ok[ii] = a[u]; ov[ii] = b[u]; } }
        }
    }
}

__device__ __forceinline__ int crow(int r, int hh) { return (r & 3) + 8 * (r >> 2) + 4 * hh; }
__device__ __forceinline__ bf16x8 vtr2(const LAS unsigned char* p) {
    const v4i16_t lo = __builtin_amdgcn_ds_read_tr16_b64_v4i16((LAS v4i16_t*)p), hi = __builtin_amdgcn_ds_read_tr16_b64_v4i16((LAS v4i16_t*)(p + 1024));
    return (bf16x8){lo[0], lo[1], lo[2], lo[3], hi[0], hi[1], hi[2], hi[3]};
}
__device__ __forceinline__ void attn_item(Frame& F, int item, LAS unsigned char* vbuf) {
    const int lane = F.lane, i = lane & 31, hh = lane >> 5;
    const int bh = item / 768; int rem = item % 768; int p, cls, qblk;
    if (rem < 256) { p = 0; cls = 0; qblk = rem; } else if (rem < 512) { p = 1; rem -= 256; cls = rem >> 6; qblk = rem & 63; } else { p = 2; rem -= 512; cls = rem >> 4; qblk = rem & 15; }
    const int lgD = 2 * p;
    const size_t hb = (size_t)bh * SEQ * HD;
    const bf16_t* Qh = F.QB + hb; const bf16_t* Kh = F.KB + hb; const bf16_t* Vh = F.VB + hb;
    const int mq0 = 32 * qblk, kb_lo = qblk >= 4 ? 0 : 4 - qblk;
    const int cswz = (lane & 7) ^ (((lane >> 4) & 1) << 2);
#define DMA_V(kb) do { const int mk0_ = mq0 - 128 + 32 * (kb); _Pragma("unroll") for (int ii = 0; ii < 4; ++ii) { \
        const bf16_t* src_ = Vh + ((size_t)(((mk0_ + 8 * ii + (lane >> 3)) << lgD) + cls) << 6) + cswz * 8; \
        __builtin_amdgcn_global_load_lds((const unsigned*)src_, (LAS unsigned*)(vbuf + ((kb) & 3) * 4096 + ii * 1024), 16, 0, 0); } } while (0)
#pragma unroll
    for (int kb = 0; kb < 5; ++kb) if (kb >= kb_lo && (kb < 4 || kb_lo > 0)) DMA_V(kb);
    bf16x8 qf[4];
    { const bf16_t* qrow = Qh + ((size_t)(((mq0 + i) << lgD) + cls) << 6) + 8 * hh;
#pragma unroll
      for (int s = 0; s < 4; ++s) qf[s] = *(const bf16x8*)(qrow + 16 * s); }
    f32x16 sacc[5];
#pragma unroll
    for (int kb = 0; kb < 5; ++kb) {
#pragma unroll
        for (int r = 0; r < 16; ++r) sacc[kb][r] = 0.f;
        if (kb >= kb_lo) {
            const bf16_t* krow = Kh + ((size_t)(((mq0 - 128 + 32 * kb + i) << lgD) + cls) << 6) + 8 * hh;
            bf16x8 kf[4];
#pragma unroll
            for (int s = 0; s < 4; ++s) kf[s] = *(const bf16x8*)(krow + 16 * s);
#pragma unroll
            for (int s = 0; s < 4; ++s) sacc[kb] = __builtin_amdgcn_mfma_f32_32x32x16_bf16(kf[s], qf[s], sacc[kb], 0, 0, 0);
        }
    }
    float mx = -INFINITY;
#pragma unroll
    for (int kb = 0; kb < 5; ++kb) if (kb >= kb_lo) {
#pragma unroll
        for (int r = 0; r < 16; ++r) { float s = sacc[kb][r]; if (kb == 0 && crow(r, hh) < i) s = -INFINITY; if (kb == 4 && crow(r, hh) > i) s = -INFINITY; sacc[kb][r] = s; mx = fmaxf(mx, s); } }
    mx = fmaxf(mx, __shfl_xor(mx, 32));
    float lsum = 0.f;
#pragma unroll
    for (int kb = 0; kb < 5; ++kb) if (kb >= kb_lo) {
#pragma unroll
        for (int r = 0; r < 16; ++r) { const float e = __builtin_amdgcn_exp2f(sacc[kb][r] - mx); sacc[kb][r] = e; lsum += e; } }
    lsum += __shfl_xor(lsum, 32);
    const int q4 = (lane & 15) >> 2, pp = lane & 3, g1 = (lane >> 4) & 1, sw = (lane >> 3) & 1;
    const int lbase = (4 * hh + q4) * 128 + (2 * g1 + (pp >> 1)) * 16 + 8 * (pp & 1);
    const int loff0 = lbase + sw * 64, loff1 = lbase + (1 - sw) * 64;
    f32x16 ot[2];
#pragma unroll
    for (int r = 0; r < 16; ++r) { ot[0][r] = 0.f; ot[1][r] = 0.f; }
    VM_WAIT();
#pragma unroll
    for (int kb = 0; kb < 5; ++kb) if (kb >= kb_lo) {
        if (kb == 4 && kb_lo == 0) VM_WAIT();
        const LAS unsigned char* vb = vbuf + (kb & 3) * 4096;
#pragma unroll
        for (int ks = 0; ks < 2; ++ks) {
            float pv8[8];
#pragma unroll
            for (int j = 0; j < 8; ++j) pv8[j] = sacc[kb][8 * ks + j];
            const u32x4 pw = pack8(pv8); const bf16x8 pf = __builtin_bit_cast(bf16x8, pw);
            const bf16x8 va = vtr2(vb + loff0 + ks * 2048), vbq = vtr2(vb + loff1 + ks * 2048);
            ot[0] = __builtin_amdgcn_mfma_f32_32x32x16_bf16(va, pf, ot[0], 0, 0, 0);
            ot[1] = __builtin_amdgcn_mfma_f32_32x32x16_bf16(vbq, pf, ot[1], 0, 0, 0);
        }
        if (kb == 0 && kb_lo == 0) { LDS_WAIT(); asm volatile("" ::: "memory"); DMA_V(4); }
    }
#undef DMA_V
    const float inv = 1.0f / lsum;
    const int pos = ((mq0 + i) << lgD) + cls, h = bh & 7;
    const size_t rowg = (size_t)(bh >> 3) * SEQ + pos;
    bf16_t* po = F.PO + ((size_t)p * NP + rowg) * 512 + h * HD + 4 * hh;
#pragma unroll
    for (int db = 0; db < 2; ++db)
#pragma unroll
        for (int g = 0; g < 4; ++g) { u32x2 w; w.x = pk2(ot[db][4 * g] * inv, ot[db][4 * g + 1] * inv); w.y = pk2(ot[db][4 * g + 2] * inv, ot[db][4 * g + 3] * inv);
            *(u32x2*)(po + 32 * db + 8 * g) = w; }
    if (hh == 0) F.PL[((size_t)p * NP + rowg) * NH + h] = make_float2(mx, lsum);
    LDS_WAIT();
}

__device__ __forceinline__ void sample_attn(Frame& F, int b, int h, int l, LAS float* scr) {
    const int lane = F.lane;
    LAS float* qs = scr; LAS float* sc = scr + 64;
    qs[lane] = F.QS[(size_t)(b * NH + h) * HD + lane];
    const size_t nw = (((size_t)(l * NS + b) * LC + (LC - 1)) * NH + h) * HD;
    const float* knew = F.out + O_KS + nw; const float* vnew = F.out + O_VS + nw;
    const float* kc = F.cache_k + ((size_t)(l * NS + b) * LC * NH + h) * HD; const float* vc = F.cache_v + ((size_t)(l * NS + b) * LC * NH + h) * HD;
    LDS_WAIT();
    float mloc = -INFINITY;
    for (int e = lane; e < 387; e += 64) {
        const int p = e / 129, j = e % 129, idx = LC - (j << (2 * p));
        const float* kr = j == 0 ? knew : kc + (size_t)idx * 512;
        float a = 0.f;
#pragma unroll 4
        for (int d = 0; d < HD; d += 4) { const f32x4 kv = *(const f32x4*)(kr + d); a += qs[d] * kv[0] + qs[d + 1] * kv[1] + qs[d + 2] * kv[2] + qs[d + 3] * kv[3]; }
        sc[e] = a; mloc = fmaxf(mloc, a);
    }
    const float m = wave_max(mloc);
    float ls = 0.f;
    for (int e = lane; e < 387; e += 64) { const float ev = __expf(sc[e] - m); sc[e] = ev; ls += ev; }
    const float den = wave_sum(ls);
    LDS_WAIT();
    float acc = 0.f;
#pragma unroll 4
    for (int e = 0; e < 387; ++e) {
        const int p = e / 129, j = e % 129, idx = LC - (j << (2 * p));
        const float* vr = j == 0 ? vnew : vc + (size_t)idx * 512;
        acc += sc[e] * vr[lane];
    }
    const float z = bf2f(F.ZB[(size_t)(NP + b) * 512 + h * HD + lane]);
    F.AMIX[(size_t)(NP + b) * DM + h * HD + lane] = (bf16_t)f2bf(acc / den * z);
    LDS_WAIT();
}

__device__ __forceinline__ void conv_unit(Frame& F, int unit, int l) {
    const int tid = F.tid, lane = F.lane, wave = F.wave;
    const int b = unit >> 7, t0 = (unit & 127) * 64;
    LAS bf16_t* us = (LAS bf16_t*)F.lds;
    LAS float* cas = (LAS float*)(F.lds + 49152);
    for (int idx = tid; idx < 94 * 32; idx += NTHR) { const int row = idx >> 5, c16 = idx & 31, t = t0 - 30 + row;
        u32x4 v = (u32x4){0u, 0u, 0u, 0u}; if (t >= 0) v = *(const u32x4*)(F.UB + (size_t)(b * SEQ + t) * 256 + c16 * 8);
        *(LAS u32x4*)(us + row * 256 + c16 * 8) = v; }
    __syncthreads();
    {
        const int c = tid & 255, g = tid >> 8;
        const float* aw = F.aw + (size_t)l * 31 * 256 + c;
        float w[31];
#pragma unroll
        for (int j = 0; j < 31; ++j) w[j] = aw[j * 256];
        const float bias = F.ab[l * 256 + c];
        float win[62];
#pragma unroll
        for (int j = 0; j < 62; ++j) win[j] = bf2f(us[(32 * g + j) * 256 + c]);
#pragma unroll
        for (int tt = 0; tt < 32; ++tt) { float a = bias;
#pragma unroll
            for (int j = 0; j < 31; ++j) a = fmaf(w[j], win[tt + j], a);
            cas[(32 * g + tt) * 256 + c] = a; }
    }
    __syncthreads();
    {
        const f32x4 lg = *(const f32x4*)(F.ag + l * 256 + 4 * lane), lb = *(const f32x4*)(F.alb + l * 256 + 4 * lane);
        const f32x4 c0 = *(const f32x4*)(F.cw + (size_t)l * 768 + 4 * lane), c1 = *(const f32x4*)(F.cw + (size_t)l * 768 + 256 + 4 * lane), c2 = *(const f32x4*)(F.cw + (size_t)l * 768 + 512 + 4 * lane);
        for (int rr = 0; rr < 8; ++rr) {
            const int row = wave * 8 + rr, t = t0 + row; const size_t r = (size_t)b * SEQ + t;
            const f32x4 v = *(const LAS f32x4*)(cas + row * 256 + 4 * lane);
            const float mu = wave_sum((v[0] + v[1]) + (v[2] + v[3])) * (1.f / 256.f);
            const f32x4 d = v - mu;
            const float var = wave_sum((d[0] * d[0] + d[1] * d[1]) + (d[2] * d[2] + d[3] * d[3])) * (1.f / 256.f);
            const float rs = rsqrtf(var + EPS);
            const u32x2 za = *(const u32x2*)(F.ZA + r * 256 + 4 * lane);
            const float zf[4] = {bflo(za.x), bfhi(za.x), bflo(za.y), bfhi(za.y)};
            float y[4];
#pragma unroll
            for (int k = 0; k < 4; ++k) y[k] = siluf_(d[k] * rs * lg[k] + lb[k]) * zf[k];
            u32x2 o; o.x = pk2(y[0], y[1]); o.y = pk2(y[2], y[3]);
            *(u32x2*)(F.AMIX + r * DM + 512 + 4 * lane) = o;
            const u32x2 u0 = *(const u32x2*)(F.UC + r * 256 + 4 * lane);
            u32x2 u1 = (u32x2){0u, 0u}, u2 = (u32x2){0u, 0u};
            if (t >= 1) u1 = *(const u32x2*)(F.UC + (r - 1) * 256 + 4 * lane);
            if (t >= 2) u2 = *(const u32x2*)(F.UC + (r - 2) * 256 + 4 * lane);
            const u32x2 gc = *(const u32x2*)(F.GC + r * 256 + 4 * lane);
            const float a0[4] = {bflo(u0.x), bfhi(u0.x), bflo(u0.y), bfhi(u0.y)}, a1[4] = {bflo(u1.x), bfhi(u1.x), bflo(u1.y), bfhi(u1.y)}, a2[4] = {bflo(u2.x), bfhi(u2.x), bflo(u2.y), bfhi(u2.y)};
            const float gf[4] = {bflo(gc.x), bfhi(gc.x), bflo(gc.y), bfhi(gc.y)};
#pragma unroll
            for (int k = 0; k < 4; ++k) y[k] = gf[k] * (c2[k] * a0[k] + c1[k] * a1[k] + c0[k] * a2[k]);
            o.x = pk2(y[0], y[1]); o.y = pk2(y[2], y[3]);
            *(u32x2*)(F.AMIX + r * DM + 768 + 4 * lane) = o;
        }
    }
    __syncthreads();
}

__device__ __forceinline__ void sample_conv(Frame& F, int b, int l) {
    LAS float* red = (LAS float*)F.lds;
    const int c = F.tid & 255, lane = F.lane, w = F.wave;
    const bool act = F.tid < 256;
    const size_t sa = ((size_t)(l * NS + b) * 30) * 256 + c, sc = ((size_t)(l * NS + b) * 2) * 256 + c;
    float ca = 0.f;
    if (act) {
        const float unew = F.out[O_AS + sa + 29 * 256];
        ca = F.ab[l * 256 + c];
        for (int j = 0; j < 30; ++j) { const float hv = F.st_a[sa + j * 256]; ca = fmaf(F.aw[((size_t)l * 31 + j) * 256 + c], hv, ca); if (j >= 1) F.out[O_AS + sa + (j - 1) * 256] = hv; }
        ca = fmaf(F.aw[((size_t)l * 31 + 30) * 256 + c], unew, ca);
    }
    float s = wave_sum(ca);
    if (act && lane == 0) red[w] = s;
    __syncthreads();
    const float mu = (red[0] + red[1] + red[2] + red[3]) * (1.f / 256.f);
    const float dlt = ca - mu;
    float s2 = wave_sum(dlt * dlt);
    if (act && lane == 0) red[4 + w] = s2;
    __syncthreads();
    if (act) {
        const float var = (red[4] + red[5] + red[6] + red[7]) * (1.f / 256.f);
        const float ln = dlt * rsqrtf(var + EPS) * F.ag[l * 256 + c] + F.alb[l * 256 + c];
        const size_t r = NP + b;
        F.AMIX[r * DM + 512 + c] = (bf16_t)f2bf(siluf_(ln) * bf2f(F.ZA[r * 256 + c]));
        const float ucnew = F.out[O_CS + sc + 256], h0 = F.st_c[sc], h1 = F.st_c[sc + 256];
        const float* cw = F.cw + (size_t)l * 768 + c;
        F.AMIX[r * DM + 768 + c] = (bf16_t)f2bf(bf2f(F.GC[r * 256 + c]) * (cw[512] * ucnew + cw[256] * h1 + cw[0] * h0));
        F.out[O_CS + sc] = h1;
    }
    __syncthreads();
}

__device__ __forceinline__ void at_phase(Frame& F, int l) {
    LAS unsigned char* vbuf = F.lds + F.wave * 16384;
    const int base = F.bid * 96 + F.wave * 12;
    for (int k = 0; k < 12; ++k) attn_item(F, base + k, vbuf);
    if (F.wave == 0) sample_attn(F, F.bid >> 3, F.bid & 7, l, (LAS float*)vbuf);
    VM_WAIT();
    __syncthreads();
    conv_unit(F, F.bid * 2, l);
    conv_unit(F, F.bid * 2 + 1, l);
    if (F.bid < NS) sample_conv(F, F.bid, l);
}

__device__ __forceinline__ void mix_phase(Frame& F) {
    const int gw = F.bid * NWAVE + F.wave, NGW = F.G * NWAVE, lane = F.lane, h = lane >> 3;
    for (int r = gw; r < NP; r += NGW) {
        float2 ml[3]; u32x4 o[3];
#pragma unroll
        for (int p = 0; p < 3; ++p) { ml[p] = F.PL[((size_t)p * NP + r) * NH + h]; o[p] = *(const u32x4*)(F.PO + ((size_t)p * NP + r) * 512 + lane * 8); }
        const u32x4 z = *(const u32x4*)(F.ZB + (size_t)r * 512 + lane * 8);
        const float m = fmaxf(fmaxf(ml[0].x, ml[1].x), ml[2].x);
        float w[3]; float den = 0.f;
#pragma unroll
        for (int p = 0; p < 3; ++p) { w[p] = __builtin_amdgcn_exp2f(ml[p].x - m) * ml[p].y; den += w[p]; }
        const float inv = 1.0f / den;
        float y[8];
#pragma unroll
        for (int k = 0; k < 4; ++k) {
            const float lo = (w[0] * bflo(o[0][k]) + w[1] * bflo(o[1][k]) + w[2] * bflo(o[2][k])) * inv, hi = (w[0] * bfhi(o[0][k]) + w[1] * bfhi(o[1][k]) + w[2] * bfhi(o[2][k])) * inv;
            y[2 * k] = lo * bflo(z[k]); y[2 * k + 1] = hi * bfhi(z[k]);
        }
        *(u32x4*)(F.AMIX + (size_t)r * DM + lane * 8) = pack8(y);
    }
}

__device__ __forceinline__ void sample_outproj(Frame& F, int l) {
    const int gw = F.bid * NWAVE + F.wave, lane = F.lane;
    if (gw >= NS * 16) return;
    const int b = gw >> 4, cg0 = (gw & 15) * 64;
    const size_t r = NP + b;
    const u32x4 a0 = *(const u32x4*)(F.AMIX + r * DM + 16 * lane), a1 = *(const u32x4*)(F.AMIX + r * DM + 16 * lane + 8);
    float af[16];
#pragma unroll
    for (int k = 0; k < 4; ++k) { af[2 * k] = bflo(a0[k]); af[2 * k + 1] = bfhi(a0[k]); af[8 + 2 * k] = bflo(a1[k]); af[8 + 2 * k + 1] = bfhi(a1[k]); }
    const bf16_t* W = F.WoutT + (size_t)l * DM * DM;
    const float* res = l == 0 ? F.x_sample + (size_t)b * DM : F.H1 + r * DM;
    float* dst = l == 0 ? F.H1 + r * DM : F.out + O_YS + (size_t)b * DM;
    float myy = 0.f;
    for (int c = 0; c < 64; ++c) {
        const u32x4 w0 = *(const u32x4*)(W + (size_t)(cg0 + c) * DM + 16 * lane), w1 = *(const u32x4*)(W + (size_t)(cg0 + c) * DM + 16 * lane + 8);
        float d = 0.f;
#pragma unroll
        for (int k = 0; k < 4; ++k) d += af[2 * k] * bflo(w0[k]) + af[2 * k + 1] * bfhi(w0[k]) + af[8 + 2 * k] * bflo(w1[k]) + af[8 + 2 * k + 1] * bfhi(w1[k]);
        d = wave_sum(d);
        if (lane == c) myy = d + res[cg0 + c];
    }
    dst[cg0 + lane] = myy;
    if (l == 0) {
        F.XB[r * DM + cg0 + lane] = (bf16_t)f2bf(myy);
        const float ss = wave_sum(myy * myy);
        if (lane == 0) F.SSQ[r * 16 + (gw & 15)] = ss;
    }
}
template <bool COOP> __global__ void __launch_bounds__(NTHR, 2) mega(Params prm) {
    extern __shared__ __attribute__((aligned(16))) unsigned char lds_raw[];
    typedef const __attribute__((address_space(4))) unsigned char* kptr_t;
    const int ph_lo = prm.ph_lo, ph_hi = prm.ph_hi;
    for (int ph = ph_lo; ph < ph_hi; ++ph) {
        kptr_t kp = (kptr_t)__builtin_amdgcn_kernarg_segment_ptr(); asm volatile("" : "+s"(kp));
#define KARG(i) (*(const float* const __attribute__((address_space(4)))*)(kp + 8 * (i)))
        Frame F;
        F.lds = (LAS unsigned char*)lds_raw;
        { int t_ = threadIdx.x; asm volatile("" : "+v"(t_)); int b_ = blockIdx.x; asm volatile("" : "+s"(b_)); F.tid = t_; F.bid = b_; }
        F.lane = F.tid & 63; F.wave = __builtin_amdgcn_readfirstlane(F.tid >> 6); F.G = gridDim.x;
        F.x_prompt = KARG(0); F.x_sample = KARG(1); F.cache_k = KARG(2); F.cache_v = KARG(3); F.st_a = KARG(4); F.st_c = KARG(5); F.ln_g = KARG(6); F.w_in = KARG(7);
        F.qg = KARG(8); F.kg = KARG(9); F.aw = KARG(10); F.ab = KARG(11); F.ag = KARG(12); F.alb = KARG(13); F.cw = KARG(14); F.w_out = KARG(15);
        F.out = (float*)KARG(16);
        unsigned char* ws = (unsigned char*)KARG(17);
#undef KARG
        F.WinT = (bf16_t*)(ws + WS_WIN); F.WoutT = (bf16_t*)(ws + WS_WOUT); F.ROPE = (float2*)(ws + WS_ROPE); F.SSQ = (float*)(ws + WS_SSQ); F.QS = (float*)(ws + WS_QS); F.PL = (float2*)(ws + WS_PL);
        F.XB = (bf16_t*)(ws + WS_XB); F.AMIX = (bf16_t*)(ws + WS_AMIX); F.QB = (bf16_t*)(ws + WS_QB); F.KB = (bf16_t*)(ws + WS_KB); F.VB = (bf16_t*)(ws + WS_VB); F.ZB = (bf16_t*)(ws + WS_ZB);
        F.UB = (bf16_t*)(ws + WS_UB); F.ZA = (bf16_t*)(ws + WS_ZA); F.UC = (bf16_t*)(ws + WS_UC); F.GC = (bf16_t*)(ws + WS_GC); F.PO = (bf16_t*)(ws + WS_PO); F.H1 = (float*)(ws + WS_H1);
        if (ph == 0) p0_prologue(F);
        else {
            const int l = (ph - 1) >> 2, k = (ph - 1) & 3;
            if (k == 0) {
                pg8::Gemm g{F.XB, F.WinT + (size_t)l * DIN * DM, MPAD, DIN, DM}; pg8::StaticOrder S; S.init(MPAD, DIN, F.G, F.bid);
                EpiIn E{ws, F.out, F.qg + l * HD, F.kg + l * HD, l};
                pg8::gemm_phase<EpiIn, pg8::StaticOrder, true, true>(F.lds, g, S, E);
            } else if (k == 1) at_phase(F, l);
            else if (k == 2) mix_phase(F);
            else {
                pg8::Gemm g{F.AMIX, F.WoutT + (size_t)l * DM * DM, NP, DM, DM}; pg8::StaticOrder S; S.init(NP, DM, F.G, F.bid);
                EpiOut E{l == 0 ? F.x_prompt : F.H1, l == 0 ? F.H1 : F.out + O_Y, ws, l};
                pg8::gemm_phase<EpiOut, pg8::StaticOrder, true, true>(F.lds, g, S, E);
                sample_outproj(F, l);
            }
        }
        if (ph + 1 < ph_hi) { if constexpr (COOP) cg::this_grid().sync(); }
    }
}

#if DIAG
__device__ __forceinline__ void err_acc(float* ERR, int stage, float d2, float b2) {
    d2 = wave_sum(d2); b2 = wave_sum(b2);
    if ((threadIdx.x & 63) == 0) { atomicAdd(ERR + 2 * stage, d2); atomicAdd(ERR + 2 * stage + 1, b2); }
}
template <int S> __global__ void __launch_bounds__(256) chk(const float* Pn, const float* MIXn, const float* H1n, unsigned char* ws, const float* out, float* ERR, long n) {
    const bf16_t* QB = (const bf16_t*)(ws + WS_QB); const bf16_t* KB = (const bf16_t*)(ws + WS_KB); const bf16_t* VB = (const bf16_t*)(ws + WS_VB); const bf16_t* ZB = (const bf16_t*)(ws + WS_ZB);
    const bf16_t* UB = (const bf16_t*)(ws + WS_UB); const bf16_t* ZA = (const bf16_t*)(ws + WS_ZA); const bf16_t* UC = (const bf16_t*)(ws + WS_UC); const bf16_t* GC = (const bf16_t*)(ws + WS_GC);
    const bf16_t* AMIX = (const bf16_t*)(ws + WS_AMIX); const float* H1 = (const float*)(ws + WS_H1); const bf16_t* XB = (const bf16_t*)(ws + WS_XB); const float* QS = (const float*)(ws + WS_QS);
    float d2 = 0.f, b2 = 0.f;
    for (long idx = (long)blockIdx.x * blockDim.x + threadIdx.x; idx < n; idx += (long)gridDim.x * blockDim.x) {
        float a = 0.f, b = 0.f;
        if (S >= 1 && S <= 3) {
            const int t = (int)(idx >> 9), h = (int)((idx >> 6) & 7), d = (int)(idx & 63);
            const bf16_t* B = S == 1 ? QB : (S == 2 ? KB : VB);
            a = bf2f(B[((size_t)(3 * NH + h) * SEQ + t) * HD + d]);
            b = Pn[(size_t)t * DIN + (S - 1) * 512 + h * 64 + d] * (S == 1 ? 0.125f * LOG2E : 1.f);
        } else if (S == 4) {
            const int rl = (int)(idx >> 9), col = (int)(idx & 511);
            a = bf2f(ZB[(size_t)(R0 + rl) * 512 + col]); b = siluf_(Pn[(size_t)rl * DIN + C_Z + col]);
        } else if (S >= 5 && S <= 8) {
            const int rl = (int)(idx >> 8), c = (int)(idx & 255); const float* pr = Pn + (size_t)rl * DIN; const size_t o = (size_t)(R0 + rl) * 256 + c;
            if (S == 5) { a = bf2f(UB[o]); b = pr[C_AV + c] * sigmoidf_(pr[C_AG + c]); }
            if (S == 6) { a = bf2f(ZA[o]); b = siluf_(pr[C_ZA + c]); }
            if (S == 7) { a = bf2f(UC[o]); b = pr[C_CC + c] * pr[C_CH + c]; }
            if (S == 8) { a = bf2f(GC[o]); b = pr[C_CB + c] * siluf_(pr[C_ZC + c]); }
        } else if (S == 9) {
            const int which = (int)(idx >> 20), tt = (int)((idx >> 9) & 2047), hd = (int)(idx & 511);
            a = out[(which == 0 ? O_KP : O_VP) + ((size_t)(0 * NB + 3) * LC + tt) * 512 + hd];
            b = Pn[(size_t)(SEQ - LC + tt) * DIN + (which == 0 ? C_K : C_V) + hd];
        } else if (S == 10) {
            long i = idx;
            if (i < 30 * 256) { const int tt = (int)(i >> 8), c = (int)(i & 255); const float* pr = Pn + (size_t)(SEQ - 30 + tt) * DIN; a = out[O_AP + ((size_t)3 * 30 + tt) * 256 + c]; b = pr[C_AV + c] * sigmoidf_(pr[C_AG + c]); }
            else if ((i -= 30 * 256) < 2 * 256) { const int tt = (int)(i >> 8), c = (int)(i & 255); const float* pr = Pn + (size_t)(SEQ - 2 + tt) * DIN; a = out[O_CP + ((size_t)3 * 2 + tt) * 256 + c]; b = pr[C_CC + c] * pr[C_CH + c]; }
            else if ((i -= 2 * 256) < 2 * NS * 512) { const int which = (int)(i / (NS * 512)), bb = (int)((i / 512) % NS), hd = (int)(i & 511); const float* pr = Pn + (size_t)(SEQ + bb) * DIN;
                a = out[(which == 0 ? O_KS : O_VS) + ((size_t)bb * LC + (LC - 1)) * 512 + hd]; b = pr[(which == 0 ? C_K : C_V) + hd]; }
            else if ((i -= 2 * NS * 512) < NS * 256) { const int bb = (int)(i >> 8), c = (int)(i & 255); const float* pr = Pn + (size_t)(SEQ + bb) * DIN; a = out[O_AS + ((size_t)bb * 30 + 29) * 256 + c]; b = pr[C_AV + c] * sigmoidf_(pr[C_AG + c]); }
            else if ((i -= NS * 256) < NS * 256) { const int bb = (int)(i >> 8), c = (int)(i & 255); const float* pr = Pn + (size_t)(SEQ + bb) * DIN; a = out[O_CS + ((size_t)bb * 2 + 1) * 256 + c]; b = pr[C_CC + c] * pr[C_CH + c]; }
            else { i -= NS * 256; const int bb = (int)(i >> 9), hd = (int)(i & 511); a = QS[(size_t)bb * 512 + hd]; b = Pn[(size_t)(SEQ + bb) * DIN + C_Q + hd] * 0.125f; }
        } else if (S >= 11 && S <= 13) {
            int t, col; if (S == 11) { t = (int)(idx >> 9); col = (int)(idx & 511); } else { t = (int)(idx >> 8); col = (S == 12 ? 512 : 768) + (int)(idx & 255); }
            a = bf2f(AMIX[(size_t)(R0 + t) * DM + col]); b = MIXn[(size_t)t * DM + col];
        } else if (S >= 14 && S <= 16) {
            int bb, col; if (S == 14) { bb = (int)(idx >> 9); col = (int)(idx & 511); } else { bb = (int)(idx >> 8); col = (S == 15 ? 512 : 768) + (int)(idx & 255); }
            a = bf2f(AMIX[(size_t)(NP + bb) * DM + col]); b = MIXn[(size_t)(SEQ + bb) * DM + col];
        } else if (S == 17) {
            a = H1[(size_t)R0 * DM + idx]; b = H1n[idx];
        } else if (S == 18) {
            a = H1[(size_t)NP * DM + idx]; b = H1n[(size_t)SEQ * DM + idx];
        } else if (S == 19) {
            a = bf2f(XB[(size_t)R0 * DM + idx]); b = H1n[idx];
        }
        const float df = a - b; d2 += df * df; b2 += b * b;
        if (!(df == df)) d2 = INFINITY;
    }
    err_acc(ERR, S, d2, b2);
}
__global__ void __launch_bounds__(256) chk_h1_delta(const float* H1, const float* H1n, const float* xp, const float* xs, float* ERR) {
    float d2 = 0.f, b2 = 0.f, d2s = 0.f, b2s = 0.f;
    for (long idx = (long)blockIdx.x * blockDim.x + threadIdx.x; idx < (long)NRN * DM; idx += (long)gridDim.x * blockDim.x) {
        const int rl = (int)(idx >> 10); const int r = R0 + rl; const int c = (int)(idx & 1023);
        const float x = r < NP ? xp[(size_t)r * DM + c] : xs[(size_t)(r - NP) * DM + c];
        const float a = H1[(size_t)r * DM + c] - x, b = H1n[idx] - x, df = a - b;
        if (r < NP) { d2 += df * df; b2 += b * b; if (!(df == df)) d2 = INFINITY; } else { d2s += df * df; b2s += b * b; if (!(df == df)) d2s = INFINITY; }
    }
    err_acc(ERR, 20, d2, b2); err_acc(ERR, 21, d2s, b2s);
}
__global__ void diag_encode(const float* ERR, float* out, int nstage) {
    if (threadIdx.x != 0 || blockIdx.x != 0) return;
    float v = 100.f;
    for (int s = 1; s <= nstage; ++s) {
        const float d2 = ERR[2 * s], b2 = ERR[2 * s + 1];
        if (d2 == 0.f && b2 == 0.f) continue;
        const float ratio = d2 / b2;
        if (!(ratio <= 4e-4f)) {
            float mant = 9.9f;
            if (ratio == ratio && ratio < 1e30f) { const float err = sqrtf(ratio); mant = 1.f + 2.f * log10f(err / 0.001f); mant = fminf(fmaxf(mant, 1.f), 9.8f); }
            v = mant * __powf(10.f, (float)(2 + s)); break;
        }
    }
    out[0] = v;
}
#endif

extern "C" void kernel_launch(void* const* d_in, const int* in_sizes, int n_in, void* d_out, int out_size, void* d_ws, size_t ws_size, hipStream_t stream) {
    static int grid = 0;
    if (grid == 0) {
        int dev = 0, cus = 0, per_cu = 0;
        hipGetDevice(&dev); hipDeviceGetAttribute(&cus, hipDeviceAttributeMultiprocessorCount, dev);
        hipFuncSetAttribute((const void*)mega<true>, hipFuncAttributeMaxDynamicSharedMemorySize, LDS_BYTES);
        hipFuncSetAttribute((const void*)mega<false>, hipFuncAttributeMaxDynamicSharedMemorySize, LDS_BYTES);
        hipOccupancyMaxActiveBlocksPerMultiprocessor(&per_cu, (const void*)mega<true>, NTHR, LDS_BYTES);
        if (per_cu < 1) { fprintf(stderr, "kernel_launch: occupancy query reports %d blocks per CU\n", per_cu); per_cu = 1; }
        (void)hipGetLastError();
        grid = cus;
        if (grid != 256) fprintf(stderr, "kernel_launch: %d CUs (built for 256)\n", grid);
    }
    Params p{};
    for (int i = 0; i < 16; ++i) p.in[i] = (const float*)d_in[i];
    p.out = (float*)d_out; p.ws = (unsigned char*)d_ws;
#if DIAG
    {
        const float* x_prompt = p.in[0]; const float* x_sample = p.in[1]; const float* cache_k = p.in[2]; const float* cache_v = p.in[3];
        unsigned char* ws = p.ws; float* out = p.out;
        float* XNn = (float*)(ws + WS_NXN); float* Pn = (float*)(ws + WS_NP); float* H1n = (float*)(ws + WS_NH1); float* MIXn = XNn; float* ERR = (float*)(ws + WS_ERR);
        hipMemsetAsync(ERR, 0, 4096, stream);
        const int l = 0;
        hipLaunchKernelGGL(nv_rmsnorm, dim3(NRN / 4), dim3(256), 0, stream, x_prompt, x_sample, p.in[6] + l * DM, XNn);
        hipLaunchKernelGGL(nv_gemm<false>, dim3(DIN / 64, (NRN + 63) / 64), dim3(256), 0, stream, (const float*)XNn, p.in[7] + (size_t)l * DM * DIN, Pn, NRN, DIN, DM, nullptr, nullptr);
        hipLaunchKernelGGL(nv_qkv_post, dim3((NRN * NH * 2 + 3) / 4), dim3(256), 0, stream, Pn, p.in[8] + l * HD, p.in[9] + l * HD);
        hipLaunchKernelGGL(nv_attn, dim3(NRN * NH / 4), dim3(256), 0, stream, (const float*)Pn, cache_k, cache_v, MIXn, l);
        hipLaunchKernelGGL(nv_conv, dim3(NRN), dim3(256), 0, stream, (const float*)Pn, p.in[4], p.in[5], p.in[10] + l * 31 * 256, p.in[11] + l * 256, p.in[12] + l * 256, p.in[13] + l * 256, p.in[14] + l * 3 * 256, MIXn, l);
        hipLaunchKernelGGL(nv_gemm<true>, dim3(DM / 64, (NRN + 63) / 64), dim3(256), 0, stream, (const float*)MIXn, p.in[15] + (size_t)l * DM * DM, H1n, NRN, DM, DM, x_prompt, x_sample);
        for (int ph = 0; ph < DIAG_PHASES; ++ph) { p.ph_lo = ph; p.ph_hi = ph + 1; hipLaunchKernelGGL(mega<false>, dim3(grid), dim3(NTHR), LDS_BYTES, stream, p); }
#define CHK(S, n) hipLaunchKernelGGL(chk<S>, dim3(1024), dim3(256), 0, stream, (const float*)Pn, (const float*)MIXn, (const float*)H1n, ws, (const float*)out, ERR, (long)(n))
        CHK(1, (long)SEQ * 512); CHK(2, (long)SEQ * 512); CHK(3, (long)SEQ * 512); CHK(4, (long)NRN * 512);
        CHK(5, (long)NRN * 256); CHK(6, (long)NRN * 256); CHK(7, (long)NRN * 256); CHK(8, (long)NRN * 256);
        CHK(9, 2L * LC * 512); CHK(10, 30 * 256 + 2 * 256 + 2 * NS * 512 + NS * 256 + NS * 256 + NS * 512);
        CHK(11, (long)SEQ * 512); CHK(12, (long)SEQ * 256); CHK(13, (long)SEQ * 256); CHK(14, (long)NS * 512); CHK(15, (long)NS * 256); CHK(16, (long)NS * 256);
        CHK(19, (long)NRN * DM);
        hipLaunchKernelGGL(chk_h1_delta, dim3(1024), dim3(256), 0, stream, (const float*)(ws + WS_H1), (const float*)H1n, x_prompt, x_sample, ERR);
        hipLaunchKernelGGL(diag_encode, dim3(1), dim3(64), 0, stream, (const float*)ERR, out, DIAG_NSTAGE);
    }
#else
    p.ph_lo = 0; p.ph_hi = N_PHASES;
    void* args[] = {&p};
    hipError_t e = hipLaunchCooperativeKernel((const void*)mega<true>, dim3(grid), dim3(NTHR), args, LDS_BYTES, stream);
    if (e != hipSuccess) fprintf(stderr, "kernel_launch: cooperative launch failed: %s (grid %d)\n", hipGetErrorString(e), grid);
#endif
}
```
